# Optimizing an MI355X kernel written in HIP

```python
import jax
import jax.numpy as jnp
from jax import lax
import numpy as np

D_MODEL = 1024
BATCH = 8
SEQ = 8192
DEPTH = 2

RWKV_HEADS = 8
RWKV_HEAD_DIM = 64
RWKV_W = RWKV_HEADS * RWKV_HEAD_DIM
DECAY_LORA = 64
ICLR_LORA = 64
GATE_LORA = 128
VRES_LORA = 32
GN_EPS = 64e-5
GMLP_GROUPS = 4
GMLP_W = 512
GMLP_GROUP_DIM = GMLP_W // GMLP_GROUPS
CHUNK = 128
LRU_HEADS = 8
LRU_W = 512
LRU_HEAD_DIM = LRU_W // LRU_HEADS
CONV_WIDTH = 4
LRU_C = 8.0
N_BRANCH = 3
BRANCH_W = 512
D_FF = 2816
LN_EPS = 1e-5
ALPHA = (2 * DEPTH) ** 0.25
BETA = (8 * DEPTH) ** -0.25

OFF_R = 0
OFF_K = OFF_R + RWKV_W
OFF_V = OFF_K + RWKV_W
OFF_W = OFF_V + RWKV_W
OFF_A = OFF_W + DECAY_LORA
OFF_G = OFF_A + ICLR_LORA
RWKV_COLS = OFF_G + GATE_LORA
OFF_GU = RWKV_COLS
OFF_GV = OFF_GU + GMLP_W
OFF_LX = OFF_GV + GMLP_W
OFF_LY = OFF_LX + LRU_W
OFF_GATE = OFF_LY + LRU_W
N_IN = OFF_GATE + N_BRANCH * D_MODEL

kernel_name = 'hybrid_rwkv7_gmlp_rglru_deepnorm'


def layer_norm(x, g, b, eps=LN_EPS):
    xf = x.astype(jnp.float32)
    mu = jnp.mean(xf, -1, keepdims=True)
    var = jnp.mean(jnp.square(xf - mu), -1, keepdims=True)
    y = (xf - mu) * lax.rsqrt(var + eps) * g.astype(jnp.float32) + b.astype(jnp.float32)
    return y.astype(x.dtype)


def swiglu(x, w1, w3, w2):
    return (jax.nn.silu(x @ w1) * (x @ w3)) @ w2


def token_shift(z):
    return jnp.pad(z, ((0, 0), (1, 0), (0, 0)))[:, :-1]


def rwkv7_wkv(r, w, k, v, kk, a):
    B, _, H, N = r.shape
    xs = tuple(jnp.swapaxes(t, 0, 1) for t in (r, w, k, v, kk, a))

    def step(state, inp):
        r_t, w_t, k_t, v_t, kk_t, a_t = inp
        sa = jnp.einsum('bhvk,bhk->bhv', state, -kk_t)
        state = (state * w_t[:, :, None, :]
                 + sa[..., None] * (kk_t * a_t)[:, :, None, :]
                 + v_t[..., None] * k_t[:, :, None, :])
        return state, jnp.einsum('bhvk,bhk->bhv', state, r_t)

    state0 = jnp.zeros((B, H, N, N), jnp.float32)
    _, out = lax.scan(step, state0, xs)
    return jnp.swapaxes(out, 0, 1)


def rwkv7_branch(z, v_first, w0, w2, a0, a2, g2, k_k, k_a, r_k, gn_g, gn_b, vres):
    B, S, _ = z.shape
    f32 = jnp.float32
    heads = lambda t: t.reshape(B, S, RWKV_HEADS, RWKV_HEAD_DIM).astype(f32)
    r = z[..., OFF_R:OFF_K]
    k = z[..., OFF_K:OFF_V]
    v = z[..., OFF_V:OFF_W]
    zw = z[..., OFF_W:OFF_A]
    za = z[..., OFF_A:OFF_G]
    zg = z[..., OFF_G:RWKV_COLS]
    v_raw = v
    if vres is not None:
        v0, v1, v2 = vres
        v = v + (v_first - v) * jax.nn.sigmoid(v0 + (v @ v1) @ v2)
    w_log = -jax.nn.softplus(-(w0 + jnp.tanh(zw) @ w2)) - 0.5
    decay = jnp.exp(-jnp.exp(w_log.astype(f32)))
    a = jax.nn.sigmoid(a0 + za @ a2)
    g = jax.nn.sigmoid(zg) @ g2
    kk = heads(k * k_k)
    kk = kk / jnp.maximum(jnp.linalg.norm(kk, axis=-1, keepdims=True), 1e-12)
    k = k * (1.0 + (a - 1.0) * k_a)
    rh, kh, vh = heads(r), heads(k), heads(v)
    o = rwkv7_wkv(rh, heads(decay), kh, vh, kk, heads(a))
    mu = jnp.mean(o, -1, keepdims=True)
    var = jnp.mean(jnp.square(o - mu), -1, keepdims=True)
    o = ((o - mu) * lax.rsqrt(var + GN_EPS)).reshape(B, S, RWKV_W) * gn_g + gn_b
    bonus = jnp.sum(rh * kh * r_k, -1, keepdims=True) * vh
    o = (o + bonus.reshape(B, S, RWKV_W)) * g
    return o.astype(z.dtype), v_raw


def gmlp_branch(zu, zv, ln_g, ln_b, ws, sb):
    B, S, _ = zu.shape
    u = jax.nn.gelu(zu)
    v = layer_norm(jax.nn.gelu(zv), ln_g, ln_b)
    vc = v.reshape(B, S // CHUNK, CHUNK, GMLP_GROUPS, GMLP_GROUP_DIM)
    mask = jnp.tril(jnp.ones((CHUNK, CHUNK), dtype=bool))
    wm = jnp.where(mask[None], ws, jnp.zeros_like(ws))
    s = jnp.einsum('gts,bcsgd->bctgd', wm, vc) + jnp.swapaxes(sb, 0, 1)[None, None, :, :, None]
    return u * s.reshape(B, S, GMLP_W)


def rglru_branch(zx, zy, conv_w, conv_b, wa, ba, wx, bx, lam):
    B, S, _ = zx.shape
    f32 = jnp.float32
    y = jax.nn.gelu(zy)
    xp = jnp.pad(zx, ((0, 0), (CONV_WIDTH - 1, 0), (0, 0)))
    xc = conv_b + xp[:, 0:S] * conv_w[0]
    for j in range(1, CONV_WIDTH):
        xc = xc + xp[:, j:j + S] * conv_w[j]
    xh = xc.reshape(B, S, LRU_HEADS, LRU_HEAD_DIM)
    rg = jax.nn.sigmoid(jnp.einsum('bshi,hij->bshj', xh, wa) + ba).reshape(B, S, LRU_W)
    ig = jax.nn.sigmoid(jnp.einsum('bshi,hij->bshj', xh, wx) + bx).reshape(B, S, LRU_W)
    log_a = -LRU_C * rg.astype(f32) * jax.nn.softplus(-lam.astype(f32))
    a = jnp.exp(log_a)
    b = jnp.sqrt(-jnp.expm1(2.0 * log_a)) * (ig * xc).astype(f32)

    def combine(left, right):
        a_l, b_l = left
        a_r, b_r = right
        return a_l * a_r, a_r * b_l + b_r

    _, h = lax.associative_scan(combine, (a, b), axis=1)
    return y * h.astype(zx.dtype)


def hybrid_mixer(x, w_in, gate_b, p_branch, w_out, mu, v_first, rwkv_p, vres, gmlp_p, lru_p):
    B, S, _ = x.shape
    z = x @ w_in
    zr = z[..., :RWKV_COLS]
    zr = zr + mu * (token_shift(zr) - zr)
    o_rwkv, v_raw = rwkv7_branch(zr, v_first, *rwkv_p, vres)
    o_gmlp = gmlp_branch(z[..., OFF_GU:OFF_GV], z[..., OFF_GV:OFF_LX], *gmlp_p)
    o_lru = rglru_branch(z[..., OFF_LX:OFF_LY], z[..., OFF_LY:OFF_GATE], *lru_p)
    gates = jax.nn.sigmoid(z[..., OFF_GATE:].reshape(B, S, N_BRANCH, D_MODEL) + gate_b)
    merged = (gates[:, :, 0] * (o_rwkv @ p_branch[0])
              + gates[:, :, 1] * (o_gmlp @ p_branch[1])
              + gates[:, :, 2] * (o_lru @ p_branch[2]))
    return merged @ w_out, v_raw


def setup_inputs(seed: int = 0) -> dict:
    key = jax.random.key(seed)
    ks = iter(jax.random.split(key, 48))
    f32 = jnp.float32

    def nrm(shape, scale):
        return jax.random.normal(next(ks), shape, f32) * scale

    x = nrm((BATCH, SEQ, D_MODEL), 1.0)
    ln_g = 1.0 + nrm((DEPTH, 3, D_MODEL), 0.02)
    ln_b = nrm((DEPTH, 3, D_MODEL), 0.02)
    ffn_w1 = nrm((DEPTH, 2, D_MODEL, D_FF), D_MODEL ** -0.5)
    ffn_w3 = nrm((DEPTH, 2, D_MODEL, D_FF), D_MODEL ** -0.5)
    ffn_w2 = nrm((DEPTH, 2, D_FF, D_MODEL), BETA * D_FF ** -0.5)
    w_in = nrm((DEPTH, D_MODEL, N_IN), D_MODEL ** -0.5)
    gate_b = nrm((DEPTH, N_BRANCH, D_MODEL), 0.02)
    p_branch = nrm((DEPTH, N_BRANCH, BRANCH_W, D_MODEL), BRANCH_W ** -0.5)
    w_out = nrm((DEPTH, D_MODEL, D_MODEL), BETA * D_MODEL ** -0.5)
    rwkv_mu = jax.random.uniform(next(ks), (DEPTH, RWKV_COLS), f32)
    rwkv_w0 = jnp.tile(jnp.linspace(-6.0, -1.0, RWKV_HEAD_DIM, dtype=f32), RWKV_HEADS)[None, :] + nrm((DEPTH, RWKV_W), 0.1)
    rwkv_w2 = nrm((DEPTH, DECAY_LORA, RWKV_W), 0.1 * DECAY_LORA ** -0.5)
    rwkv_a0 = nrm((DEPTH, RWKV_W), 0.1)
    rwkv_a2 = nrm((DEPTH, ICLR_LORA, RWKV_W), 0.5 * ICLR_LORA ** -0.5)
    rwkv_g2 = nrm((DEPTH, GATE_LORA, RWKV_W), GATE_LORA ** -0.5)
    rwkv_k_k = 0.85 + nrm((DEPTH, RWKV_W), 0.05)
    rwkv_k_a = 1.0 + nrm((DEPTH, RWKV_W), 0.05)
    rwkv_r_k = nrm((DEPTH, RWKV_HEADS, RWKV_HEAD_DIM), 0.1)
    rwkv_gn_g = 1.0 + nrm((DEPTH, RWKV_W), 0.02)
    rwkv_gn_b = nrm((DEPTH, RWKV_W), 0.02)
    rwkv_v0 = 1.0 + nrm((DEPTH - 1, RWKV_W), 0.1)
    rwkv_v1 = nrm((DEPTH - 1, RWKV_W, VRES_LORA), RWKV_W ** -0.5)
    rwkv_v2 = nrm((DEPTH - 1, VRES_LORA, RWKV_W), 0.5 * VRES_LORA ** -0.5)
    gmlp_ln_g = 1.0 + nrm((DEPTH, GMLP_W), 0.02)
    gmlp_ln_b = nrm((DEPTH, GMLP_W), 0.02)
    gmlp_ws = nrm((DEPTH, GMLP_GROUPS, CHUNK, CHUNK), CHUNK ** -0.5)
    gmlp_sb = 1.0 + nrm((DEPTH, GMLP_GROUPS, CHUNK), 0.1)
    lru_conv_w = nrm((DEPTH, CONV_WIDTH, LRU_W), CONV_WIDTH ** -0.5)
    lru_conv_b = nrm((DEPTH, LRU_W), 0.02)
    lru_wa = nrm((DEPTH, LRU_HEADS, LRU_HEAD_DIM, LRU_HEAD_DIM), LRU_HEAD_DIM ** -0.5)
    lru_ba = nrm((DEPTH, LRU_HEADS, LRU_HEAD_DIM), 0.02)
    lru_wx = nrm((DEPTH, LRU_HEADS, LRU_HEAD_DIM, LRU_HEAD_DIM), LRU_HEAD_DIM ** -0.5)
    lru_bx = nrm((DEPTH, LRU_HEADS, LRU_HEAD_DIM), 0.02)
    u = jax.random.uniform(next(ks), (DEPTH, LRU_W), f32, 0.9, 0.999)
    s = u ** (1.0 / LRU_C)
    lru_lam = jnp.log(s) - jnp.log1p(-s)
    return {'x': x, 'ln_g': ln_g, 'ln_b': ln_b, 'ffn_w1': ffn_w1, 'ffn_w3': ffn_w3, 'ffn_w2': ffn_w2,
            'w_in': w_in, 'gate_b': gate_b, 'p_branch': p_branch, 'w_out': w_out,
            'rwkv_mu': rwkv_mu, 'rwkv_w0': rwkv_w0, 'rwkv_w2': rwkv_w2, 'rwkv_a0': rwkv_a0, 'rwkv_a2': rwkv_a2,
            'rwkv_g2': rwkv_g2, 'rwkv_k_k': rwkv_k_k, 'rwkv_k_a': rwkv_k_a, 'rwkv_r_k': rwkv_r_k,
            'rwkv_gn_g': rwkv_gn_g, 'rwkv_gn_b': rwkv_gn_b, 'rwkv_v0': rwkv_v0, 'rwkv_v1': rwkv_v1, 'rwkv_v2': rwkv_v2,
            'gmlp_ln_g': gmlp_ln_g, 'gmlp_ln_b': gmlp_ln_b, 'gmlp_ws': gmlp_ws, 'gmlp_sb': gmlp_sb,
            'lru_conv_w': lru_conv_w, 'lru_conv_b': lru_conv_b, 'lru_wa': lru_wa, 'lru_ba': lru_ba,
            'lru_wx': lru_wx, 'lru_bx': lru_bx, 'lru_lam': lru_lam}


def reference(x, ln_g, ln_b, ffn_w1, ffn_w3, ffn_w2, w_in, gate_b, p_branch, w_out,
              rwkv_mu, rwkv_w0, rwkv_w2, rwkv_a0, rwkv_a2, rwkv_g2, rwkv_k_k, rwkv_k_a, rwkv_r_k,
              rwkv_gn_g, rwkv_gn_b, rwkv_v0, rwkv_v1, rwkv_v2,
              gmlp_ln_g, gmlp_ln_b, gmlp_ws, gmlp_sb,
              lru_conv_w, lru_conv_b, lru_wa, lru_ba, lru_wx, lru_bx, lru_lam):
    v_first = None
    for l in range(DEPTH):
        x = layer_norm(ALPHA * x + 0.5 * swiglu(x, ffn_w1[l, 0], ffn_w3[l, 0], ffn_w2[l, 0]), ln_g[l, 0], ln_b[l, 0])
        vres = None if l == 0 else (rwkv_v0[l - 1], rwkv_v1[l - 1], rwkv_v2[l - 1])
        rwkv_p = (rwkv_w0[l], rwkv_w2[l], rwkv_a0[l], rwkv_a2[l], rwkv_g2[l], rwkv_k_k[l], rwkv_k_a[l],
                  rwkv_r_k[l], rwkv_gn_g[l], rwkv_gn_b[l])
        gmlp_p = (gmlp_ln_g[l], gmlp_ln_b[l], gmlp_ws[l], gmlp_sb[l])
        lru_p = (lru_conv_w[l], lru_conv_b[l], lru_wa[l], lru_ba[l], lru_wx[l], lru_bx[l], lru_lam[l])
        y, v_raw = hybrid_mixer(x, w_in[l], gate_b[l], p_branch[l], w_out[l], rwkv_mu[l], v_first,
                                rwkv_p, vres, gmlp_p, lru_p)
        if l == 0:
            v_first = v_raw
        x = layer_norm(ALPHA * x + y, ln_g[l, 1], ln_b[l, 1])
        x = layer_norm(ALPHA * x + 0.5 * swiglu(x, ffn_w1[l, 1], ffn_w3[l, 1], ffn_w2[l, 1]), ln_g[l, 2], ln_b[l, 2])
    return x
```

```cpp
#include <hip/hip_runtime.h>
#include <hip/hip_cooperative_groups.h>
#include <cstdio>
namespace cg = cooperative_groups;

#ifndef STOP_AFTER
#define STOP_AFTER 1000
#endif
#ifndef DIGEST_OFF_MIB
#define DIGEST_OFF_MIB 0
#endif
#ifndef ONE_LAUNCH
#define ONE_LAUNCH 1
#endif

#define LAS __attribute__((address_space(3)))
typedef unsigned short bf16_t;
typedef short bf16x8 __attribute__((ext_vector_type(8)));
typedef short bf16x4 __attribute__((ext_vector_type(4)));
typedef float f32x4 __attribute__((ext_vector_type(4)));
typedef float f32x2 __attribute__((ext_vector_type(2)));
typedef unsigned u32x4 __attribute__((ext_vector_type(4)));
typedef unsigned u32x2 __attribute__((ext_vector_type(2)));

constexpr int T = 65536, DM = 1024, FF = 2816, SEQ = 8192;
constexpr float ALPHA = 1.4142135623730951f;
constexpr float LN_EPS = 1e-5f, GN_EPS = 64e-5f;
constexpr int LDS_BYTES = 136 * 1024;
constexpr size_t MiB = 1ull << 20;
constexpr size_t WS_STATS = 6 * MiB + 1280 * 1024  , WS_IDENT = 6 * MiB + 1792 * 1024  , WS_XBAR = 3840 * 1024, WS_HALO = 0, WS_LRUS = 4 * MiB, WS_SMALL = 6 * MiB, WS_W13 = 8 * MiB, WS_W2 = 52 * MiB, WS_WIN = 74 * MiB, WS_PB = 101 * MiB, WS_WO = 107 * MiB,
                 WS_XB = 112 * MiB, WS_VF = 240 * MiB, WS_R = 304 * MiB;
constexpr size_t BLK = 64 * MiB;
constexpr size_t WS_B0 = WS_R, WS_B1 = WS_R + BLK, WS_B2 = WS_R + 2 * BLK, WS_B3 = WS_R + 3 * BLK, WS_B4 = WS_R + 4 * BLK, WS_B5 = WS_R + 5 * BLK, WS_B6 = WS_R + 6 * BLK,
                 WS_B7 = WS_R + 7 * BLK, WS_LD = WS_B7 + 32 * MiB, WS_KK = WS_LD + BLK, WS_BB = WS_KK + BLK, WS_END = WS_BB + BLK;
constexpr int SM_W2T = 0, SM_A2T = 32768, SM_G2T = 65536, SM_WAT = 131072, SM_WXT = 163840, SM_WM = 196608, SM_L = 262144, SM_V1T = 2 * SM_L, SM_V2T = SM_V1T + 16384;

__device__ __forceinline__ float bf2f(bf16_t h) { return __uint_as_float(((unsigned)h) << 16); }
__device__ __forceinline__ float bfs2f(short h) { return __uint_as_float(((unsigned)(unsigned short)h) << 16); }
__device__ __forceinline__ bf16_t f2bf(float f) { unsigned u = __float_as_uint(f); u += 0x7FFFu + ((u >> 16) & 1u); return (bf16_t)(u >> 16); }
typedef __bf16 bf16x2_t __attribute__((ext_vector_type(2)));
__device__ __forceinline__ unsigned cvt_pk_bf16(float lo, float hi) { const f32x2 v = {lo, hi}; const bf16x2_t b = __builtin_convertvector(v, bf16x2_t); return __builtin_bit_cast(unsigned, b); }
__device__ __forceinline__ u32x2 pack4(float a, float b, float c, float d) { u32x2 r; r.x = cvt_pk_bf16(a, b); r.y = cvt_pk_bf16(c, d); return r; }
__device__ __forceinline__ void unpack4(u32x2 p, float* o) { o[0] = __uint_as_float(p.x << 16); o[1] = __uint_as_float(p.x & 0xFFFF0000u); o[2] = __uint_as_float(p.y << 16); o[3] = __uint_as_float(p.y & 0xFFFF0000u); }
__device__ __forceinline__ void unpack8(u32x4 p, float* o) { unpack4((u32x2){p.x, p.y}, o); unpack4((u32x2){p.z, p.w}, o + 4); }
__device__ __forceinline__ float sigmoidf_(float x) { return __builtin_amdgcn_rcpf(1.0f + __expf(-x)); }
__device__ __forceinline__ float siluf_(float x) { return x * sigmoidf_(x); }
__device__ __forceinline__ float tanhf_(float u) { return 1.0f - 2.0f * __builtin_amdgcn_rcpf(1.0f + __expf(2.0f * u)); }
__device__ __forceinline__ float geluf_(float x) { return 0.5f * x * (1.0f + tanhf_(0.7978845608028654f * (x + 0.044715f * x * x * x))); }
__device__ __forceinline__ float softplusf_(float x) { return fmaxf(x, 0.f) + __logf(1.0f + __expf(-fabsf(x))); }
__device__ __forceinline__ float softplus_precise(float x) { return fmaxf(x, 0.f) + log1pf(__expf(-fabsf(x))); }
template <int CTRL> __device__ __forceinline__ float dppf(float v) { return __int_as_float(__builtin_amdgcn_update_dpp(0, __float_as_int(v), CTRL, 0xF, 0xF, true)); }
template <int CTRL> __device__ __forceinline__ float dppf_old(float old, float v) { return __int_as_float(__builtin_amdgcn_update_dpp(__float_as_int(old), __float_as_int(v), CTRL, 0xF, 0xF, false)); }
__device__ __forceinline__ float wave_sum(float v) {
#pragma unroll
    for (int o = 1; o < 64; o <<= 1) v += __shfl_xor(v, o);
    return v;
}
#define MFMA16(a, b, c) __builtin_amdgcn_mfma_f32_16x16x32_bf16((a), (b), (c), 0, 0, 0)

namespace pg8 {
#define PG8_LAS __attribute__((address_space(3)))
constexpr int BM = 256, BK = 64, HALF = 128, HTB = HALF * BK * 2, STAGE_BYTES = 8 * HTB, NXCD = 8, WGM = 8;
__host__ __device__ __forceinline__ int lds_byte(int r, int c) { const int st = (r >> 4) * 2 + (c >> 5), rr = r & 15, cc = c & 31, ob = rr * 64 + cc * 2; return st * 1024 + (ob ^ (((ob >> 9) & 1) << 5)); }
__host__ __device__ __forceinline__ void stage_rc(int b, int& R, int& C) { const int st = b / 1024, sb = b % 1024, swz = sb ^ (((sb >> 9) & 1) << 5); R = (st >> 1) * 16 + swz / 64; C = (st & 1) * 32 + (swz % 64) / 2; }
__host__ __device__ __forceinline__ int perm32(int rho) { const int n = rho >> 4, i = rho & 15; return 8 * (i >> 2) + 4 * n + (i & 3); }
struct Unit { int pm, pn; };
struct Gemm { const bf16_t* A; const bf16_t* Bt; int M, N, K; };
struct StaticOrder {
    int nM, nN, nwg, G, c;
    __host__ __device__ void init(int M, int N, int G_, int c_) { nM = M / BM; nN = N / BM; nwg = nM * nN; G = G_; c = c_; }
    __host__ __device__ bool next(int i, Unit& u) const {
        const long L = (long)i * G + c; if (L >= nwg) return false;
        int wgid = (int)L; { const int q = nwg / NXCD, r = nwg % NXCD, xcd = wgid % NXCD, off = wgid / NXCD; wgid = (xcd < r ? xcd * (q + 1) : r * (q + 1) + (xcd - r) * q) + off; }
        const int nig = WGM * nN, gid = wgid / nig, fm = gid * WGM, gsz = (nM - fm) < WGM ? (nM - fm) : WGM;
        u.pm = fm + ((wgid % nig) % gsz); u.pn = (wgid % nig) / gsz; return true;
    }
    __device__ __forceinline__ void a_ready(const Unit&) const {}
    __device__ __forceinline__ void done(const Unit&) const {}
};

struct EpiSwiglu {
    static constexpr bool PERM = true, AFTER_DRAIN = false;
    bf16_t* H;
    __device__ __forceinline__ void operator()(const f32x4 (&acc)[2][2][4][2], const Unit& u, int wr, int wc, int fr, int fq) const {
        const int row0 = u.pm * BM + wr * 64 + fr, col0 = u.pn * 128 + wc * 32 + 8 * fq;
#pragma unroll
        for (int ai = 0; ai < 2; ++ai)
#pragma unroll
            for (int m = 0; m < 4; ++m) {
                bf16_t* rowp = H + (size_t)(row0 + ai * HALF + m * 16) * FF + col0;
                const f32x4 a0 = acc[ai][0][m][0], a1 = acc[ai][0][m][1], b0 = acc[ai][1][m][0], b1 = acc[ai][1][m][1];
                u32x4 w;
                w.x = cvt_pk_bf16(siluf_(a0[0]) * b0[0], siluf_(a0[1]) * b0[1]); w.y = cvt_pk_bf16(siluf_(a0[2]) * b0[2], siluf_(a0[3]) * b0[3]);
                w.z = cvt_pk_bf16(siluf_(a1[0]) * b1[0], siluf_(a1[1]) * b1[1]); w.w = cvt_pk_bf16(siluf_(a1[2]) * b1[2], siluf_(a1[3]) * b1[3]);
                *(u32x4*)rowp = w;
            }
    }
};
struct EpiResF32 {
    static constexpr bool PERM = false, AFTER_DRAIN = false;
    float* X; const float* U; const f32x2* stats; const float* g; const float* b; float alpha, scale;
    __device__ __forceinline__ void operator()(const f32x4 (&acc)[2][2][4][2], const Unit& u, int wr, int wc, int fr, int fq) const {
        const int row0 = u.pm * BM + wr * 64 + fr, col0 = u.pn * BM + wc * 32 + 4 * fq;
        f32x4 ga[2][2], ba[2][2];
#pragma unroll
        for (int bj = 0; bj < 2; ++bj)
#pragma unroll
            for (int n = 0; n < 2; ++n) { ga[bj][n] = *(const f32x4*)(g + col0 + bj * HALF + n * 16) * alpha; ba[bj][n] = *(const f32x4*)(b + col0 + bj * HALF + n * 16) * alpha; }
#pragma unroll
        for (int ai = 0; ai < 2; ++ai)
#pragma unroll
            for (int m = 0; m < 4; ++m) { const int row = row0 + ai * HALF + m * 16; const size_t ro = (size_t)row * DM + col0;
                const f32x2 st = stats[row]; const float rs = st.y, nm = -st.x * st.y;
#pragma unroll
                for (int bj = 0; bj < 2; ++bj)
#pragma unroll
                    for (int n = 0; n < 2; ++n) { const size_t o = ro + bj * HALF + n * 16; const f32x4 t = *(const f32x4*)(U + o) * rs + nm;
                        *(f32x4*)(X + o) = (t * ga[bj][n] + ba[bj][n]) + acc[ai][bj][m][n] * scale; } }
    }
};
struct EpiZ {
    static constexpr bool PERM = true, AFTER_DRAIN = false;
    bf16_t* Z; bf16_t* halo;
    __device__ __forceinline__ void operator()(const f32x4 (&acc)[2][2][4][2], const Unit& u, int wr, int wc, int fr, int fq) const {
        const int row0 = u.pm * BM + wr * 64 + fr; const int pn = u.pn;
        bf16_t* base; int ldc, colt;
        if (pn < 14) { base = Z + (size_t)(pn >> 1) * T * 512; ldc = 512; colt = (pn & 1) * 256; } else { base = Z + (size_t)7 * T * 512; ldc = 256; colt = 0; }
        const bool dohalo = (pn < 6) || (pn == 14); const int hc = (pn < 6 ? pn * 256 : 1536) + wc * 32 + 8 * fq;
        const int col0 = colt + wc * 32 + 8 * fq;
#pragma unroll
        for (int ai = 0; ai < 2; ++ai)
#pragma unroll
            for (int m = 0; m < 4; ++m) { const int row = row0 + ai * HALF + m * 16; bf16_t* rowp = base + (size_t)row * ldc + col0;
#pragma unroll
                for (int bj = 0; bj < 2; ++bj) { const f32x4 v0 = acc[ai][bj][m][0], v1 = acc[ai][bj][m][1];
                    u32x4 w; w.x = cvt_pk_bf16(v0[0], v0[1]); w.y = cvt_pk_bf16(v0[2], v0[3]); w.z = cvt_pk_bf16(v1[0], v1[1]); w.w = cvt_pk_bf16(v1[2], v1[3]);
                    *(u32x4*)(rowp + bj * HALF) = w;
                    if (dohalo && (row & 63) == 63) *(u32x4*)(halo + (size_t)(row >> 6) * 1792 + hc + bj * HALF) = w; } }
    }
};
struct EpiBf {
    static constexpr bool PERM = true, AFTER_DRAIN = false;
    bf16_t* O; int ldc;
    __device__ __forceinline__ void operator()(const f32x4 (&acc)[2][2][4][2], const Unit& u, int wr, int wc, int fr, int fq) const {
        const int row0 = u.pm * BM + wr * 64 + fr, col0 = u.pn * BM + wc * 32 + 8 * fq;
#pragma unroll
        for (int ai = 0; ai < 2; ++ai)
#pragma unroll
            for (int m = 0; m < 4; ++m) { bf16_t* rowp = O + (size_t)(row0 + ai * HALF + m * 16) * ldc + col0;
#pragma unroll
                for (int bj = 0; bj < 2; ++bj) { const f32x4 v0 = acc[ai][bj][m][0], v1 = acc[ai][bj][m][1];
                    u32x4 w; w.x = cvt_pk_bf16(v0[0], v0[1]); w.y = cvt_pk_bf16(v0[2], v0[3]); w.z = cvt_pk_bf16(v1[0], v1[1]); w.w = cvt_pk_bf16(v1[2], v1[3]);
                    *(u32x4*)(rowp + bj * HALF) = w; } }
    }
};

struct EpiMergeF {
    static constexpr bool PERM = true, AFTER_DRAIN = false;
    const bf16_t* G; bf16_t* Mg; const float* bias; int first;
    __device__ __forceinline__ void operator()(const f32x4 (&acc)[2][2][4][2], const Unit& u, int wr, int wc, int fr, int fq) const {
        const int row0 = u.pm * BM + wr * 64 + fr, col0 = u.pn * BM + wc * 32 + 8 * fq;
#pragma unroll
        for (int bj = 0; bj < 2; ++bj) {
            const f32x4 b0 = *(const f32x4*)(bias + col0 + bj * HALF), b1 = *(const f32x4*)(bias + col0 + bj * HALF + 4);
#pragma unroll
            for (int ai = 0; ai < 2; ++ai)
#pragma unroll
                for (int m = 0; m < 4; ++m) { const size_t off = (size_t)(row0 + ai * HALF + m * 16) * DM + col0 + bj * HALF;
                    const f32x4 v0 = acc[ai][bj][m][0], v1 = acc[ai][bj][m][1];
                    float g[8], o[8]; unpack8(*(const u32x4*)(G + off), g);
                    if (first) {
#pragma unroll
                        for (int j = 0; j < 8; ++j) o[j] = 0.f;
                    } else unpack8(*(const u32x4*)(Mg + off), o);
#pragma unroll
                    for (int j = 0; j < 4; ++j) { o[j] += sigmoidf_(g[j] + b0[j]) * v0[j]; o[4 + j] += sigmoidf_(g[4 + j] + b1[j]) * v1[j]; }
                    u32x4 w; w.x = cvt_pk_bf16(o[0], o[1]); w.y = cvt_pk_bf16(o[2], o[3]); w.z = cvt_pk_bf16(o[4], o[5]); w.w = cvt_pk_bf16(o[6], o[7]);
                    *(u32x4*)(Mg + off) = w; }
        }
    }
};

template <class Epi, class Sched, bool ALIGN_EPI = true, bool SP2 = true>
__device__ __forceinline__ void gemm_phase(PG8_LAS unsigned char* lds, const Gemm g, const Sched& S, const Epi& E) {
    int tid_ = threadIdx.x; asm volatile("" : "+v"(tid_));
    const int tid = tid_, wid = __builtin_amdgcn_readfirstlane(tid >> 6), lane = tid & 63, wr = wid >> 2, wc = wid & 3, fr = lane & 15, fq = lane >> 4;
    const int K = g.K, nt = K / BK;
    unsigned voffA[2], voffB[2];
#pragma unroll
    for (int i = 0; i < 2; ++i) { int R, C; stage_rc(tid * 16 + i * 8192, R, C); const int Rb = Epi::PERM ? ((R & ~31) + perm32(R & 31)) : R;
        voffA[i] = (unsigned)(R * K + C) * 2u; voffB[i] = (unsigned)(Rb * K + C) * 2u; }
    const size_t kstep = (size_t)(BK * 2);
    const size_t hstep = (size_t)HALF * K * 2;
    const size_t tstep = 2 * hstep;
    const unsigned ldsw = (unsigned)wid * 1024u;
    const int aoff = lds_byte(wr * 64 + fr, fq * 8), boff = lds_byte(wc * 32 + fr, fq * 8);
#define PG8_SA(b, h) (((b) * 2 + (h)) * HTB)
#define PG8_SB(b, h) ((4 + (b) * 2 + (h)) * HTB)
#define PG8_STAGE(bufoff, gbase, voff) do { _Pragma("unroll") for (int _i = 0; _i < 2; ++_i) \
        __builtin_amdgcn_global_load_lds((const unsigned*)((const char*)(gbase) + (voff)[_i]), (PG8_LAS unsigned*)(lds + (bufoff) + ldsw + _i * 8192), 16, 0, 0); } while (0)
#define PG8_LDA(dst, b, h) do { _Pragma("unroll") for (int m = 0; m < 4; ++m) _Pragma("unroll") for (int k = 0; k < 2; ++k) dst[m][k] = *(const PG8_LAS bf16x8*)(lds + PG8_SA(b, h) + aoff + m * 2048 + k * 1024); } while (0)
#define PG8_LDB(dst, b, h) do { _Pragma("unroll") for (int n = 0; n < 2; ++n) _Pragma("unroll") for (int k = 0; k < 2; ++k) dst[n][k] = *(const PG8_LAS bf16x8*)(lds + PG8_SB(b, h) + boff + n * 2048 + k * 1024); } while (0)
#define PG8_MMA(ai, bj, At, Bt) do { __builtin_amdgcn_s_setprio(1); _Pragma("unroll") for (int m = 0; m < 4; ++m) _Pragma("unroll") for (int n = 0; n < 2; ++n) _Pragma("unroll") for (int k = 0; k < 2; ++k) \
        acc[ai][bj][m][n] = __builtin_amdgcn_mfma_f32_16x16x32_bf16(Bt[n][k], At[m][k], acc[ai][bj][m][n], 0, 0, 0); __builtin_amdgcn_s_setprio(0); } while (0)
#define PG8_WAIT_V(n) asm volatile("s_waitcnt vmcnt(" #n ")" ::: "memory")
#define PG8_WAIT_L(n) asm volatile("s_waitcnt lgkmcnt(" #n ")" ::: "memory")
#define PG8_BAR __builtin_amdgcn_s_barrier()
#define PG8_SCHED __builtin_amdgcn_sched_barrier(0)
    Unit cur, nxt; int ui = 0;
    if (!S.next(0, cur)) return;
    f32x4 acc[2][2][4][2];
#pragma unroll
    for (int a = 0; a < 2; ++a)
#pragma unroll
        for (int b = 0; b < 2; ++b)
#pragma unroll
            for (int m = 0; m < 4; ++m)
#pragma unroll
                for (int n = 0; n < 2; ++n) acc[a][b][m][n] = (f32x4){0.f, 0.f, 0.f, 0.f};
    bf16x8 At[4][2], B0[2][2], B1[2][2];
    const char* cA = (const char*)g.A + (size_t)cur.pm * tstep; const char* cB = (const char*)g.Bt + (size_t)cur.pn * tstep;
    S.a_ready(cur);
    if constexpr (SP2) {
        PG8_STAGE(PG8_SB(0, 0), cB, voffB); PG8_STAGE(PG8_SB(0, 1), cB + hstep, voffB); PG8_STAGE(PG8_SA(0, 0), cA, voffA); PG8_STAGE(PG8_SA(0, 1), cA + hstep, voffA);
        if (wr == 1) PG8_BAR;
        PG8_WAIT_V(2); PG8_BAR;
        PG8_STAGE(PG8_SB(1, 0), cB + kstep, voffB); PG8_STAGE(PG8_SA(1, 0), cA + kstep, voffA); PG8_STAGE(PG8_SB(1, 1), cB + hstep + kstep, voffB);
        PG8_WAIT_V(6); PG8_BAR;
    } else {
        PG8_STAGE(PG8_SB(0, 0), cB, voffB); PG8_STAGE(PG8_SA(0, 0), cA, voffA); PG8_STAGE(PG8_SB(0, 1), cB + hstep, voffB); PG8_STAGE(PG8_SA(0, 1), cA + hstep, voffA);
        if (wr == 1) PG8_BAR;
        PG8_WAIT_V(4); PG8_BAR;
        PG8_STAGE(PG8_SB(1, 0), cB + kstep, voffB); PG8_STAGE(PG8_SA(1, 0), cA + kstep, voffA); PG8_STAGE(PG8_SB(1, 1), cB + hstep + kstep, voffB);
        PG8_WAIT_V(6); PG8_BAR;
    }
    for (;;) {
        const bool has_next = S.next(ui + 1, nxt);
        const char* nA = has_next ? (const char*)g.A + (size_t)nxt.pm * tstep : cA; const char* nB = has_next ? (const char*)g.Bt + (size_t)nxt.pn * tstep : cB;
        for (int t = 0; t < nt; t += 2) {
            const bool last = (t == nt - 2);
            const char* a1 = cA + (size_t)(t + 1) * kstep;
            const char* a2 = last ? nA : cA + (size_t)(t + 2) * kstep; const char* b2 = last ? nB : cB + (size_t)(t + 2) * kstep;
            const char* a3 = a2 + kstep; const char* b3 = b2 + kstep;
            if (last && has_next) S.a_ready(nxt);
            if constexpr (SP2) {
            PG8_LDB(B0, 0, 0); PG8_LDB(B1, 0, 1); PG8_SCHED; PG8_LDA(At, 0, 0); PG8_STAGE(PG8_SA(1, 1), a1 + hstep, voffA);
            PG8_WAIT_V(8); PG8_WAIT_L(0); PG8_BAR; PG8_MMA(0, 0, At, B0); PG8_MMA(0, 1, At, B1); PG8_BAR; PG8_SCHED;
            PG8_LDA(At, 0, 1); PG8_STAGE(PG8_SB(0, 0), b2, voffB); PG8_STAGE(PG8_SB(0, 1), b2 + hstep, voffB); PG8_STAGE(PG8_SA(0, 0), a2, voffA);
            PG8_WAIT_V(8); PG8_WAIT_L(0); PG8_BAR; PG8_MMA(1, 0, At, B0); PG8_MMA(1, 1, At, B1); PG8_BAR; PG8_SCHED;
            PG8_LDB(B0, 1, 0); PG8_LDB(B1, 1, 1); PG8_SCHED; PG8_LDA(At, 1, 0); PG8_STAGE(PG8_SA(0, 1), a2 + hstep, voffA);
            PG8_WAIT_V(8); PG8_WAIT_L(0); PG8_BAR; PG8_MMA(0, 0, At, B0); PG8_MMA(0, 1, At, B1); PG8_BAR; PG8_SCHED;
            PG8_LDA(At, 1, 1); PG8_STAGE(PG8_SB(1, 0), b3, voffB); PG8_STAGE(PG8_SB(1, 1), b3 + hstep, voffB); PG8_STAGE(PG8_SA(1, 0), a3, voffA);
            PG8_WAIT_V(8); PG8_WAIT_L(0); PG8_BAR; PG8_MMA(1, 0, At, B0); PG8_MMA(1, 1, At, B1); PG8_BAR; PG8_SCHED;
            } else {
            PG8_LDB(B0, 0, 0); PG8_SCHED; PG8_LDA(At, 0, 0); PG8_STAGE(PG8_SA(1, 1), a1 + hstep, voffA);
            PG8_WAIT_L(8); PG8_BAR; PG8_WAIT_L(0); PG8_MMA(0, 0, At, B0); PG8_BAR; PG8_SCHED;
            PG8_LDB(B1, 0, 1); PG8_STAGE(PG8_SB(0, 0), b2, voffB);
            PG8_BAR; PG8_WAIT_L(0); PG8_MMA(0, 1, At, B1); PG8_BAR;
            PG8_LDA(At, 0, 1); PG8_STAGE(PG8_SA(0, 0), a2, voffA);
            PG8_BAR; PG8_WAIT_L(0); PG8_MMA(1, 0, At, B0); PG8_BAR; PG8_SCHED;
            PG8_STAGE(PG8_SB(0, 1), b2 + hstep, voffB);
            PG8_WAIT_V(6); PG8_BAR; PG8_MMA(1, 1, At, B1); PG8_BAR;
            PG8_LDB(B0, 1, 0); PG8_SCHED; PG8_LDA(At, 1, 0); PG8_STAGE(PG8_SA(0, 1), a2 + hstep, voffA);
            PG8_WAIT_L(8); PG8_BAR; PG8_WAIT_L(0); PG8_MMA(0, 0, At, B0); PG8_BAR; PG8_SCHED;
            PG8_LDB(B1, 1, 1); PG8_STAGE(PG8_SB(1, 0), b3, voffB);
            PG8_BAR; PG8_WAIT_L(0); PG8_MMA(0, 1, At, B1); PG8_BAR;
            PG8_LDA(At, 1, 1); PG8_STAGE(PG8_SA(1, 0), a3, voffA);
            PG8_BAR; PG8_WAIT_L(0); PG8_MMA(1, 0, At, B0); PG8_BAR; PG8_SCHED;
            PG8_STAGE(PG8_SB(1, 1), b3 + hstep, voffB);
            PG8_WAIT_V(6); PG8_BAR; PG8_MMA(1, 1, At, B1); PG8_BAR;
            }
        }
        if constexpr (ALIGN_EPI) { if (wr == 0) PG8_BAR; }
        if constexpr (!Epi::AFTER_DRAIN) { E(acc, cur, wr, wc, fr, fq); S.done(cur); }
        if (!has_next) break;
#pragma unroll
        for (int a = 0; a < 2; ++a)
#pragma unroll
            for (int b = 0; b < 2; ++b)
#pragma unroll
                for (int m = 0; m < 4; ++m)
#pragma unroll
                    for (int n = 0; n < 2; ++n) acc[a][b][m][n] = (f32x4){0.f, 0.f, 0.f, 0.f};
        cur = nxt; cA = nA; cB = nB; ++ui;
        if constexpr (ALIGN_EPI) { if (wr == 1) PG8_BAR; }
    }
    PG8_WAIT_V(0);
    if constexpr (!ALIGN_EPI) { if (wr == 0) PG8_BAR; }
    PG8_BAR;
    if constexpr (Epi::AFTER_DRAIN) { E.fused(acc, cur, wr, wc, fr, fq, lds, wid, lane); S.done(cur); }
#undef PG8_SA
#undef PG8_SB
#undef PG8_STAGE
#undef PG8_LDA
#undef PG8_LDB
#undef PG8_MMA
#undef PG8_WAIT_V
#undef PG8_WAIT_L
#undef PG8_BAR
#undef PG8_SCHED
}
}

struct Args {
    const float* in[35];
    float* out; unsigned char* ws;
    int ph_lo, ph_hi, coop, pad;
};
enum { I_X = 0, I_LNG, I_LNB, I_W1, I_W3, I_W2, I_WIN, I_GATEB, I_PB, I_WOUT, I_MU, I_W0, I_RW2, I_A0, I_A2, I_G2, I_KK, I_KA, I_RK, I_GNG, I_GNB, I_V0, I_V1, I_V2,
       I_GLNG, I_GLNB, I_GWS, I_GSB, I_CW, I_CB, I_WA, I_BA, I_WX, I_BX, I_LAM };

struct Ctx {
    const float* const* in; float* X; unsigned char* ws; unsigned char* lds; int tid, lane, wid, fr, fq, G;
    __device__ __forceinline__ void refresh() { int t = threadIdx.x; asm volatile("" : "+v"(t)); tid = t; lane = t & 63; wid = __builtin_amdgcn_readfirstlane(t >> 6); fr = lane & 15; fq = lane >> 4; }
    __device__ __forceinline__ bf16_t* wsb(size_t off) const { return (bf16_t*)(ws + off); }
    __device__ __forceinline__ bf16_t* small(int l, int off) const { return (bf16_t*)(ws + WS_SMALL) + (size_t)l * SM_L + off; }
};

__device__ __noinline__ void transpose_tiles(const float* src, int ld, int K, int ncols, bf16_t* dst, int ldd, int blk, int blkstride, int off, LAS float* tile, int rot) {
    const int ntn = ncols / 64, ntot = (K / 64) * ntn, tid = threadIdx.x, G = gridDim.x;
    const int wn = tid >> 3, wk = (tid & 7) * 8;
    for (int t = (blockIdx.x + G - (rot % G)) % G; t < ntot; t += 2 * G) {
        const int t2 = t + G; const bool has2 = t2 < ntot;
        const int k0 = (t / ntn) * 64, n0 = (t % ntn) * 64, k02 = has2 ? (t2 / ntn) * 64 : k0, n02 = has2 ? (t2 % ntn) * 64 : n0;
        float ra[8], rb[8];
#pragma unroll
        for (int i = 0; i < 8; ++i) { const int kk = (tid >> 6) + 8 * i, nn = tid & 63; ra[i] = src[(size_t)(k0 + kk) * ld + n0 + nn]; rb[i] = src[(size_t)(k02 + kk) * ld + n02 + nn]; }
#pragma unroll
        for (int i = 0; i < 8; ++i) { const int kk = (tid >> 6) + 8 * i, nn = tid & 63; tile[kk * 65 + nn] = ra[i]; }
        __syncthreads();
        { const int n = n0 + wn; const int row = (n / blk) * blkstride + (n % blk) + off; float v[8];
#pragma unroll
          for (int j = 0; j < 8; ++j) v[j] = tile[(wk + j) * 65 + wn];
          u32x4 w; w.x = cvt_pk_bf16(v[0], v[1]); w.y = cvt_pk_bf16(v[2], v[3]); w.z = cvt_pk_bf16(v[4], v[5]); w.w = cvt_pk_bf16(v[6], v[7]);
          *(u32x4*)(dst + (size_t)row * ldd + k0 + wk) = w; }
        __syncthreads();
        if (has2) {
#pragma unroll
            for (int i = 0; i < 8; ++i) { const int kk = (tid >> 6) + 8 * i, nn = tid & 63; tile[kk * 65 + nn] = rb[i]; }
        }
        __syncthreads();
        if (has2) { const int n = n02 + wn; const int row = (n / blk) * blkstride + (n % blk) + off; float v[8];
#pragma unroll
            for (int j = 0; j < 8; ++j) v[j] = tile[(wk + j) * 65 + wn];
            u32x4 w; w.x = cvt_pk_bf16(v[0], v[1]); w.y = cvt_pk_bf16(v[2], v[3]); w.z = cvt_pk_bf16(v[4], v[5]); w.w = cvt_pk_bf16(v[6], v[7]);
            *(u32x4*)(dst + (size_t)row * ldd + k02 + wk) = w; }
        __syncthreads();
    }
}
__device__ __noinline__ void small_transpose(const float* src, int K, int N, bf16_t* dst) {
    const int tot = K * N;
    for (int i = blockIdx.x * 512 + threadIdx.x; i < tot; i += gridDim.x * 512) { const int n = i / K, k = i % K; dst[i] = f2bf(src[(size_t)k * N + n]); }
}
__device__ void p0_phase(const Ctx& c) {
    LAS float* tile = (LAS float*)c.lds;
    int rot = 0;
    for (int l = 0; l < 2; ++l) {
        for (int f = 0; f < 2; ++f) {
            const int lf = l * 2 + f;
            bf16_t* w13 = c.wsb(WS_W13) + (size_t)lf * 5632 * 1024;
            transpose_tiles(c.in[I_W1] + (size_t)lf * 1024 * FF, FF, 1024, FF, w13, 1024, 128, 256, 0, tile, rot); rot += 704;
            transpose_tiles(c.in[I_W3] + (size_t)lf * 1024 * FF, FF, 1024, FF, w13, 1024, 128, 256, 128, tile, rot); rot += 704;
            transpose_tiles(c.in[I_W2] + (size_t)lf * FF * 1024, 1024, FF, 1024, c.wsb(WS_W2) + (size_t)lf * 1024 * FF, FF, 1 << 20, 0, 0, tile, rot); rot += 704;
        }
        const float* win = c.in[I_WIN] + (size_t)l * 1024 * 6912; bf16_t* wint = c.wsb(WS_WIN) + (size_t)l * 6912 * 1024;
        transpose_tiles(win, 6912, 1024, 1536, wint, 1024, 1 << 20, 0, 0, tile, rot); rot += 384;
        transpose_tiles(win + 1792, 6912, 1024, 2048, wint, 1024, 1 << 20, 0, 1536, tile, rot); rot += 512;
        transpose_tiles(win + 1536, 6912, 1024, 256, wint, 1024, 1 << 20, 0, 3584, tile, rot); rot += 64;
        transpose_tiles(win + 3840, 6912, 1024, 3072, wint, 1024, 1 << 20, 0, 3840, tile, rot); rot += 768;
        for (int i = 0; i < 3; ++i) { transpose_tiles(c.in[I_PB] + (size_t)(l * 3 + i) * 512 * 1024, 1024, 512, 1024, c.wsb(WS_PB) + (size_t)(l * 3 + i) * 1024 * 512, 512, 1 << 20, 0, 0, tile, rot); rot += 128; }
        transpose_tiles(c.in[I_WOUT] + (size_t)l * 1024 * 1024, 1024, 1024, 1024, c.wsb(WS_WO) + (size_t)l * 1024 * 1024, 1024, 1 << 20, 0, 0, tile, rot); rot += 256;
        small_transpose(c.in[I_RW2] + (size_t)l * 64 * 512, 64, 512, c.small(l, SM_W2T));
        small_transpose(c.in[I_A2] + (size_t)l * 64 * 512, 64, 512, c.small(l, SM_A2T));
        small_transpose(c.in[I_G2] + (size_t)l * 128 * 512, 128, 512, c.small(l, SM_G2T));
        for (int h = 0; h < 8; ++h) {
            small_transpose(c.in[I_WA] + (size_t)(l * 8 + h) * 4096, 64, 64, c.small(l, SM_WAT) + h * 4096);
            small_transpose(c.in[I_WX] + (size_t)(l * 8 + h) * 4096, 64, 64, c.small(l, SM_WXT) + h * 4096);
        }
        {
            const float* ws_ = c.in[I_GWS] + (size_t)l * 65536; bf16_t* wm = c.small(l, SM_WM);
            for (int i = blockIdx.x * 512 + threadIdx.x; i < 65536; i += gridDim.x * 512) { const int t = (i >> 7) & 127, s = i & 127; wm[i] = f2bf(s <= t ? ws_[i] : 0.f); }
        }
    }
    {   f32x2* st = (f32x2*)(c.ws + WS_STATS); float* idn = (float*)(c.ws + WS_IDENT);
        for (int i = blockIdx.x * 512 + threadIdx.x; i < T; i += gridDim.x * 512) st[i] = (f32x2){0.f, 1.f};
        for (int i = blockIdx.x * 512 + threadIdx.x; i < 2048; i += gridDim.x * 512) idn[i] = i < 1024 ? 1.f : 0.f; }
    small_transpose(c.in[I_V1], 512, 32, c.small(0, SM_V1T));
    small_transpose(c.in[I_V2], 32, 512, c.small(0, SM_V2T));
    const f32x4* x4 = (const f32x4*)c.in[I_X]; u32x2* xb = (u32x2*)c.wsb(WS_XB);
    {   const size_t stride = (size_t)gridDim.x * 512, n4 = (size_t)T * DM / 4;
        for (size_t i = (size_t)blockIdx.x * 512 + threadIdx.x; i < n4; i += 4 * stride) {
            f32x4 v[4];
#pragma unroll
            for (int u = 0; u < 4; ++u) v[u] = (i + u * stride < n4) ? x4[i + u * stride] : (f32x4){0.f, 0.f, 0.f, 0.f};
#pragma unroll
            for (int u = 0; u < 4; ++u) if (i + u * stride < n4) xb[i + u * stride] = pack4(v[u][0], v[u][1], v[u][2], v[u][3]);
        } }
}

__device__ void ln_phase(const Ctx& c, const float* g, const float* b, bool write_f32) {
    f32x2* stats = (f32x2*)(c.ws + WS_STATS);
    f32x4* X4 = (f32x4*)c.X; u32x2* xb = (u32x2*)c.wsb(WS_XB);
    const f32x4* g4 = (const f32x4*)g; const f32x4* b4 = (const f32x4*)b;
    f32x4 gv[4], bv[4];
#pragma unroll
    for (int j = 0; j < 4; ++j) { gv[j] = g4[c.lane + 64 * j]; bv[j] = b4[c.lane + 64 * j]; }
    constexpr int NR = 4;
    for (int row = (blockIdx.x * 8 + c.wid) * NR; row < T; row += c.G * 8 * NR) {
        f32x4 v[NR][4];
#pragma unroll
        for (int r = 0; r < NR; ++r)
#pragma unroll
            for (int j = 0; j < 4; ++j) v[r][j] = X4[(size_t)(row + r) * 256 + c.lane + 64 * j];
#pragma unroll
        for (int r = 0; r < NR; ++r) {
            float s = 0.f;
#pragma unroll
            for (int j = 0; j < 4; ++j) s += (v[r][j][0] + v[r][j][1]) + (v[r][j][2] + v[r][j][3]);
            const float mean = wave_sum(s) * (1.0f / 1024.0f); float q = 0.f;
#pragma unroll
            for (int j = 0; j < 4; ++j) { const f32x4 d = v[r][j] - mean; q += (d[0] * d[0] + d[1] * d[1]) + (d[2] * d[2] + d[3] * d[3]); }
            const float rstd = rsqrtf(wave_sum(q) * (1.0f / 1024.0f) + LN_EPS);
            if (c.lane == 0) stats[row + r] = (f32x2){mean, rstd};
#pragma unroll
            for (int j = 0; j < 4; ++j) { const f32x4 y = (v[r][j] - mean) * rstd * gv[j] + bv[j];
                if (write_f32) X4[(size_t)(row + r) * 256 + c.lane + 64 * j] = y; xb[(size_t)(row + r) * 256 + c.lane + 64 * j] = pack4(y[0], y[1], y[2], y[3]); }
        }
    }
}

template <int L1> __device__ void prep_phase(const Ctx& c, int l) {
    LAS bf16_t* XW = (LAS bf16_t*)c.lds;
    LAS bf16_t* XA = XW + 64 * 72;
    LAS bf16_t* VS = XA + 64 * 72;
    LAS bf16_t* VD = VS + 64 * 520;
    bf16_t* Rb = c.wsb(WS_B0); bf16_t* Kb = c.wsb(WS_B1); bf16_t* Vb = c.wsb(WS_B2); bf16_t* MISC = c.wsb(WS_B7);
    bf16_t* LD = c.wsb(WS_LD); bf16_t* KKo = c.wsb(WS_KK); bf16_t* BBo = c.wsb(WS_BB); bf16_t* VF = c.wsb(WS_VF);
    const bf16_t* halo = c.wsb(WS_HALO);
    const float* mu = c.in[I_MU] + l * 1792;
    const bf16_t* w2T = c.small(l, SM_W2T); const bf16_t* a2T = c.small(l, SM_A2T); const bf16_t* v1T = c.small(0, SM_V1T); const bf16_t* v2T = c.small(0, SM_V2T);
    const float* w0 = c.in[I_W0] + l * 512; const float* a0 = c.in[I_A0] + l * 512; const float* k_k = c.in[I_KK] + l * 512; const float* k_a = c.in[I_KA] + l * 512;
    const float* v0 = c.in[I_V0];
    const int tid = c.tid, w = c.wid, fr = c.fr, fq = c.fq;
    for (int tile = blockIdx.x; tile < T / 64; tile += c.G) {
        const int t0 = tile * 64; const bool seqstart = (t0 % SEQ) == 0;
        u32x4 keep[4];
        {
            const int ch = tid & 31, cc = ch * 8;
            float m8[8];
#pragma unroll
            for (int j = 0; j < 8; ++j) m8[j] = mu[1536 + cc + j];
#pragma unroll
            for (int i = 0; i < 4; ++i) {
                const int row = (tid >> 5) + 16 * i, t = t0 + row;
                float cur[8], prv[8];
                unpack8(*(const u32x4*)(MISC + (size_t)t * 256 + cc), cur);
                if (row > 0) unpack8(*(const u32x4*)(MISC + (size_t)(t - 1) * 256 + cc), prv);
                else if (seqstart) {
#pragma unroll
                    for (int j = 0; j < 8; ++j) prv[j] = 0.f;
                } else unpack8(*(const u32x4*)(halo + (size_t)(tile - 1) * 1792 + 1536 + cc), prv);
                float s[8];
#pragma unroll
                for (int j = 0; j < 8; ++j) s[j] = cur[j] + m8[j] * (prv[j] - cur[j]);
                if (ch < 8) {
#pragma unroll
                    for (int j = 0; j < 8; ++j) XW[row * 72 + cc + j] = f2bf(tanhf_(s[j]));
                } else if (ch < 16) {
#pragma unroll
                    for (int j = 0; j < 8; ++j) XA[row * 72 + cc - 64 + j] = f2bf(s[j]);
                } else {
                    keep[i].x = cvt_pk_bf16(sigmoidf_(s[0]), sigmoidf_(s[1])); keep[i].y = cvt_pk_bf16(sigmoidf_(s[2]), sigmoidf_(s[3]));
                    keep[i].z = cvt_pk_bf16(sigmoidf_(s[4]), sigmoidf_(s[5])); keep[i].w = cvt_pk_bf16(sigmoidf_(s[6]), sigmoidf_(s[7]));
                }
            }
        }
        if (L1) {
#pragma unroll 1
            for (int mt = 0; mt < 4; ++mt)
#pragma unroll
                for (int nt = 0; nt < 4; ++nt) {
                    const int rt = 16 * mt + fr, t = t0 + rt, cc = 64 * w + 16 * nt + 4 * fq;
                    float cur[4], prv[4];
                    unpack4(*(const u32x2*)(Vb + (size_t)t * 512 + cc), cur);
                    if (rt > 0) unpack4(*(const u32x2*)(Vb + (size_t)(t - 1) * 512 + cc), prv);
                    else if (seqstart) { prv[0] = prv[1] = prv[2] = prv[3] = 0.f; }
                    else unpack4(*(const u32x2*)(halo + (size_t)(tile - 1) * 1792 + 1024 + cc), prv);
                    float s[4];
#pragma unroll
                    for (int j = 0; j < 4; ++j) s[j] = cur[j] + mu[1024 + cc + j] * (prv[j] - cur[j]);
                    *(LAS u32x2*)(VS + rt * 520 + cc) = pack4(s[0], s[1], s[2], s[3]);
                }
        }
        __syncthreads();
        if ((tid & 31) >= 16) {
#pragma unroll
            for (int i = 0; i < 4; ++i) { const int row = (tid >> 5) + 16 * i; *(u32x4*)(MISC + (size_t)(t0 + row) * 256 + (tid & 31) * 8) = keep[i]; }
        }
        if (L1) {
            const int mt = w >> 1, ntl = w & 1;
            f32x4 acc = (f32x4){0.f, 0.f, 0.f, 0.f};
#pragma unroll 4
            for (int ks = 0; ks < 16; ++ks) {
                const bf16x8 first = *(const bf16x8*)(v1T + (size_t)(16 * ntl + fr) * 512 + 32 * ks + 8 * fq);
                const bf16x8 second = *(const LAS bf16x8*)(VS + (16 * mt + fr) * 520 + 32 * ks + 8 * fq);
                acc = MFMA16(first, second, acc);
            }
            *(LAS u32x2*)(VD + (16 * mt + fr) * 40 + 16 * ntl + 4 * fq) = pack4(acc[0], acc[1], acc[2], acc[3]);
            __syncthreads();
        }
#pragma unroll 1
        for (int mt = 3; mt >= 0; --mt) {
            int wz = 64 * w; asm volatile("" : "+v"(wz));
            const int rt = 16 * mt + fr, t = t0 + rt;
            f32x4 aw[4], aa[4], av[4];
#pragma unroll
            for (int nt = 0; nt < 4; ++nt) {
                aw[nt] = (f32x4){0.f, 0.f, 0.f, 0.f}; aa[nt] = (f32x4){0.f, 0.f, 0.f, 0.f}; av[nt] = (f32x4){0.f, 0.f, 0.f, 0.f};
#pragma unroll
                for (int ks = 0; ks < 2; ++ks) {
                    const bf16x8 xw = *(const LAS bf16x8*)(XW + rt * 72 + 32 * ks + 8 * fq);
                    const bf16x8 xa = *(const LAS bf16x8*)(XA + rt * 72 + 32 * ks + 8 * fq);
                    const bf16x8 fw = *(const bf16x8*)(w2T + (size_t)(wz + 16 * nt + fr) * 64 + 32 * ks + 8 * fq);
                    const bf16x8 fa = *(const bf16x8*)(a2T + (size_t)(wz + 16 * nt + fr) * 64 + 32 * ks + 8 * fq);
                    aw[nt] = MFMA16(fw, xw, aw[nt]); aa[nt] = MFMA16(fa, xa, aa[nt]);
                }
                if (L1) {
                    const bf16x8 fv = *(const bf16x8*)(v2T + (size_t)(wz + 16 * nt + fr) * 32 + 8 * fq);
                    const bf16x8 xv = *(const LAS bf16x8*)(VD + rt * 40 + 8 * fq);
                    av[nt] = MFMA16(fv, xv, av[nt]);
                }
            }
            float kkv[4][4], av_[4][4]; float sumsq = 0.f;
#pragma unroll
            for (int nt = 0; nt < 4; ++nt) {
                const int cc = wz + 16 * nt + 4 * fq;
                float cr[4], ck[4], cv[4], pr[4], pk[4], pv[4];
                unpack4(*(const u32x2*)(Rb + (size_t)t * 512 + cc), cr); unpack4(*(const u32x2*)(Kb + (size_t)t * 512 + cc), ck); unpack4(*(const u32x2*)(Vb + (size_t)t * 512 + cc), cv);
                if (rt > 0) { unpack4(*(const u32x2*)(Rb + (size_t)(t - 1) * 512 + cc), pr); unpack4(*(const u32x2*)(Kb + (size_t)(t - 1) * 512 + cc), pk); unpack4(*(const u32x2*)(Vb + (size_t)(t - 1) * 512 + cc), pv); }
                else if (seqstart) {
#pragma unroll
                    for (int j = 0; j < 4; ++j) { pr[j] = 0.f; pk[j] = 0.f; pv[j] = 0.f; }
                } else { const bf16_t* hp = halo + (size_t)(tile - 1) * 1792 + cc; unpack4(*(const u32x2*)(hp), pr); unpack4(*(const u32x2*)(hp + 512), pk); unpack4(*(const u32x2*)(hp + 1024), pv); }
                const f32x4 mur = *(const f32x4*)(mu + cc), muk = *(const f32x4*)(mu + 512 + cc), muv = *(const f32x4*)(mu + 1024 + cc);
                const f32x4 w0v = *(const f32x4*)(w0 + cc), a0v = *(const f32x4*)(a0 + cc), kkp = *(const f32x4*)(k_k + cc), kap = *(const f32x4*)(k_a + cc);
                float rs[4], ldv[4], kp[4], vp[4], vsn[4];
#pragma unroll
                for (int j = 0; j < 4; ++j) {
                    rs[j] = cr[j] + mur[j] * (pr[j] - cr[j]);
                    const float ksj = ck[j] + muk[j] * (pk[j] - ck[j]);
                    vsn[j] = cv[j] + muv[j] * (pv[j] - cv[j]);
                    const float wl = w0v[j] + aw[nt][j];
                    const float wlog = -softplusf_(-wl) - 0.5f;
                    ldv[j] = -__expf(wlog);
                    const float a = sigmoidf_(a0v[j] + aa[nt][j]);
                    av_[nt][j] = a;
                    const float kv = ksj * kkp[j];
                    kkv[nt][j] = kv; sumsq += kv * kv;
                    kp[j] = ksj * (1.0f + (a - 1.0f) * kap[j]);
                    vp[j] = vsn[j];
                }
                if (L1) {
                    float vf[4]; unpack4(*(const u32x2*)(VF + (size_t)t * 512 + cc), vf);
                    const f32x4 v0v = *(const f32x4*)(v0 + cc);
#pragma unroll
                    for (int j = 0; j < 4; ++j) vp[j] = vsn[j] + (vf[j] - vsn[j]) * sigmoidf_(v0v[j] + av[nt][j]);
                } else {
                    *(u32x2*)(VF + (size_t)t * 512 + cc) = pack4(vsn[0], vsn[1], vsn[2], vsn[3]);
                }
                *(u32x2*)(Rb + (size_t)t * 512 + cc) = pack4(rs[0], rs[1], rs[2], rs[3]);
                *(u32x2*)(Kb + (size_t)t * 512 + cc) = pack4(kp[0], kp[1], kp[2], kp[3]);
                *(u32x2*)(Vb + (size_t)t * 512 + cc) = pack4(vp[0], vp[1], vp[2], vp[3]);
                *(u32x2*)(LD + (size_t)t * 512 + cc) = pack4(ldv[0], ldv[1], ldv[2], ldv[3]);
            }
            sumsq += __shfl_xor(sumsq, 16); sumsq += __shfl_xor(sumsq, 32);
            const float inv = rsqrtf(fmaxf(sumsq, 1e-24f));
#pragma unroll
            for (int nt = 0; nt < 4; ++nt) {
                const int cc = wz + 16 * nt + 4 * fq;
                float kn[4], bb[4];
#pragma unroll
                for (int j = 0; j < 4; ++j) { kn[j] = kkv[nt][j] * inv; bb[j] = kn[j] * av_[nt][j]; }
                *(u32x2*)(KKo + (size_t)t * 512 + cc) = pack4(kn[0], kn[1], kn[2], kn[3]);
                *(u32x2*)(BBo + (size_t)t * 512 + cc) = pack4(bb[0], bb[1], bb[2], bb[3]);
            }
        }
        __syncthreads();
    }
}

__device__ void scan_phase(const Ctx& c) {
    constexpr int RW = 16;
    const int bh = blockIdx.x & 63, rq = blockIdx.x >> 6, b = bh >> 3, h = bh & 7;
    if (rq >= 64 / RW) return;
    const size_t tb = (size_t)b * SEQ; const int col0 = h * 64, rbase = rq * RW;
    LAS float* L = (LAS float*)c.lds;
    constexpr int BUFW = 6 * 2048 + 64;
    LAS float* OUT = L + 2 * BUFW;
    const bf16_t* Rb = c.wsb(WS_B0); const bf16_t* Kb = c.wsb(WS_B1); const bf16_t* Vb = c.wsb(WS_B2);
    const bf16_t* LD = c.wsb(WS_LD); const bf16_t* KKi = c.wsb(WS_KK); const bf16_t* BBo = c.wsb(WS_BB); bf16_t* OS = c.wsb(WS_B5);
    const int tid = c.tid, ss = tid >> 4, kq = (tid & 15) * 4, row = rbase + (tid >> 4), kg = tid & 15;
    const bool comp = tid < RW * 16;
    f32x4 S0 = (f32x4){0.f, 0.f, 0.f, 0.f};
    u32x2 gr, gk, gv, gl, gkk, gb;
#define SCAN_LOAD(chunk) do { const size_t o_ = (tb + (size_t)(chunk) * 32 + ss) * 512 + col0 + kq; \
        gr = *(const u32x2*)(Rb + o_); gk = *(const u32x2*)(Kb + o_); gv = *(const u32x2*)(Vb + o_); gl = *(const u32x2*)(LD + o_); gkk = *(const u32x2*)(KKi + o_); gb = *(const u32x2*)(BBo + o_); } while (0)
#define SCAN_STAGE(bufi) do { LAS float* B_ = L + (bufi) * BUFW; float r_[4], k_[4], v_[4], l_[4], n_[4], b_[4]; \
        unpack4(gr, r_); unpack4(gk, k_); unpack4(gv, v_); unpack4(gl, l_); unpack4(gkk, n_); unpack4(gb, b_); \
        float w_[4]; _Pragma("unroll") for (int j = 0; j < 4; ++j) w_[j] = __expf(l_[j]); \
        const int o_ = ss * 64 + kq; \
        *(LAS f32x4*)(B_ + o_) = (f32x4){-n_[0], -n_[1], -n_[2], -n_[3]}; \
        *(LAS f32x4*)(B_ + 2048 + o_) = (f32x4){w_[0] * r_[0], w_[1] * r_[1], w_[2] * r_[2], w_[3] * r_[3]}; \
        *(LAS f32x4*)(B_ + 4096 + o_) = (f32x4){w_[0], w_[1], w_[2], w_[3]}; \
        *(LAS f32x4*)(B_ + 6144 + o_) = (f32x4){b_[0], b_[1], b_[2], b_[3]}; \
        *(LAS f32x4*)(B_ + 8192 + o_) = (f32x4){k_[0], k_[1], k_[2], k_[3]}; \
        *(LAS f32x4*)(B_ + 10240 + o_) = (f32x4){v_[0], v_[1], v_[2], v_[3]}; \
        float br_ = (b_[0] * r_[0] + b_[1] * r_[1]) + (b_[2] * r_[2] + b_[3] * r_[3]); float kr_ = (k_[0] * r_[0] + k_[1] * r_[1]) + (k_[2] * r_[2] + k_[3] * r_[3]); \
        br_ += dppf<0xB1>(br_); kr_ += dppf<0xB1>(kr_); br_ += dppf<0x4E>(br_); kr_ += dppf<0x4E>(kr_); \
        br_ += dppf<0x141>(br_); kr_ += dppf<0x141>(kr_); br_ += dppf<0x140>(br_); kr_ += dppf<0x140>(kr_); \
        if ((tid & 15) == 0) { B_[12288 + 2 * ss] = br_; B_[12288 + 2 * ss + 1] = kr_; } } while (0)
    SCAN_LOAD(0); SCAN_STAGE(0);
    __syncthreads();
#pragma unroll 1
    for (int ch = 0; ch < SEQ / 32; ++ch) {
        if (ch + 1 < SEQ / 32) SCAN_LOAD(ch + 1);
        LAS float* B = L + (ch & 1) * BUFW;
        if (comp) {
            f32x4 A0[2], R0[2], W0[2], B0[2], K0[2]; float Vv[2], Br[2], Kr[2];
#define SCAN_FETCH(q, s_) do { const int o_ = (s_) * 64 + kg * 4; \
            A0[q] = *(LAS f32x4*)(B + o_); R0[q] = *(LAS f32x4*)(B + 2048 + o_); W0[q] = *(LAS f32x4*)(B + 4096 + o_); B0[q] = *(LAS f32x4*)(B + 6144 + o_); K0[q] = *(LAS f32x4*)(B + 8192 + o_); \
            Vv[q] = B[10240 + (s_) * 64 + row]; Br[q] = B[12288 + 2 * (s_)]; Kr[q] = B[12288 + 2 * (s_) + 1]; } while (0)
#define SCAN_STEP(q, s_) do { \
            const f32x4 pa = S0 * A0[q], pr = S0 * R0[q]; \
            float p0 = (pa[0] + pa[1]) + (pa[2] + pa[3]), p1 = (pr[0] + pr[1]) + (pr[2] + pr[3]); \
            p0 += dppf<0xB1>(p0); p1 += dppf<0xB1>(p1); p0 += dppf<0x4E>(p0); p1 += dppf<0x4E>(p1); p0 += dppf<0x141>(p0); p1 += dppf<0x141>(p1); p0 += dppf<0x140>(p0); p1 += dppf<0x140>(p1); \
            const float v_ = Vv[q]; \
            S0 = S0 * W0[q] + (B0[q] * p0 + K0[q] * v_); \
            const float o_ = p1 + p0 * Br[q] + v_ * Kr[q]; \
            OUT[(s_) * (RW * 16) + tid] = o_; } while (0)
            SCAN_FETCH(0, 0);
#pragma unroll
            for (int s = 0; s < 32; s += 2) {
                SCAN_FETCH(1, s + 1);
                SCAN_STEP(0, s);
                if (s + 2 < 32) SCAN_FETCH(0, s + 2);
                SCAN_STEP(1, s + 1);
            }
#undef SCAN_FETCH
#undef SCAN_STEP
        }
        __syncthreads();
        { const int st = tid >> 4, r = tid & 15; OS[(tb + (size_t)ch * 32 + st) * 512 + col0 + rbase + r] = f2bf(OUT[st * (RW * 16) + r * 16]); }
        if (ch + 1 < SEQ / 32) SCAN_STAGE((ch + 1) & 1);
        __syncthreads();
    }
#undef SCAN_LOAD
#undef SCAN_STAGE
}

__device__ void gmlp_lru_phase(const Ctx& c, int l, int first_wg) {
    LAS float* ST = (LAS float*)c.lds;
    LAS bf16_t* VT = (LAS bf16_t*)(c.lds + 1024);
    LAS bf16_t* WL = (LAS bf16_t*)(c.lds + 36864);
    bf16_t* GU = c.wsb(WS_B3); bf16_t* GV = c.wsb(WS_B4); const bf16_t* LX = c.wsb(WS_B5); bf16_t* LY = c.wsb(WS_B6);
    float* Pend = (float*)(c.ws + WS_LRUS); float* Hend = Pend + 512 * 512;
    const float* lng = c.in[I_GLNG] + l * 512; const float* lnb = c.in[I_GLNB] + l * 512; const float* sb = c.in[I_GSB] + l * 512;
    const bf16_t* Wm = c.small(l, SM_WM); const bf16_t* waT = c.small(l, SM_WAT); const bf16_t* wxT = c.small(l, SM_WXT);
    const float* cw = c.in[I_CW] + l * 4 * 512; const float* cb = c.in[I_CB] + l * 512; const float* ba = c.in[I_BA] + l * 512; const float* bx = c.in[I_BX] + l * 512; const float* lam = c.in[I_LAM] + l * 512;
    const int tid = c.tid, w = c.wid, fr = c.fr, fq = c.fq, lane = c.lane;
    const int nwg = c.G - first_wg;
    for (int tile = blockIdx.x - first_wg; tile < T / 128; tile += nwg) {
        const int t0 = tile * 128; const int pos0 = t0 % SEQ;
#pragma unroll 4
        for (int i = 0; i < 16; ++i) {
            const int rt = 16 * w + i; float x[8]; unpack8(*(const u32x4*)(GV + (size_t)(t0 + rt) * 512 + lane * 8), x);
            float s = 0.f;
#pragma unroll
            for (int j = 0; j < 8; ++j) { x[j] = geluf_(x[j]); s += x[j]; }
            const float mean = wave_sum(s) * (1.0f / 512.0f); float q = 0.f;
#pragma unroll
            for (int j = 0; j < 8; ++j) { const float d = x[j] - mean; q += d * d; }
            const float rstd = rsqrtf(wave_sum(q) * (1.0f / 512.0f) + LN_EPS);
            if (lane == 0) { ST[2 * rt] = mean; ST[2 * rt + 1] = rstd; }
        }
        __syncthreads();
#pragma unroll 1
        for (int g = 0; g < 4; ++g) {
#pragma unroll
            for (int i = 0; i < 4; ++i) {
                const int idx = tid + 512 * i, s = idx >> 4, dc = (idx & 15) * 8;
                float x[8]; unpack8(*(const u32x4*)(GV + (size_t)(t0 + s) * 512 + g * 128 + dc), x);
                const float mean = ST[2 * s], rstd = ST[2 * s + 1];
#pragma unroll
                for (int j = 0; j < 8; ++j) VT[(dc + j) * 136 + s] = f2bf((geluf_(x[j]) - mean) * rstd * lng[g * 128 + dc + j] + lnb[g * 128 + dc + j]);
            }
#pragma unroll
            for (int i = 0; i < 4; ++i) { const int idx = tid + 512 * i, tr = idx >> 4, sc = (idx & 15) * 8;
                *(LAS u32x4*)(WL + tr * 136 + sc) = *(const u32x4*)(Wm + (size_t)g * 16384 + tr * 128 + sc); }
            __syncthreads();
#pragma unroll 1
            for (int tbk = 0; tbk < 8; ++tbk) {
                f32x4 acc = (f32x4){0.f, 0.f, 0.f, 0.f};
                const int nks = (tbk >> 1) + 1;
                for (int ks = 0; ks < nks; ++ks) {
                    const bf16x8 first = *(const LAS bf16x8*)(VT + (16 * w + fr) * 136 + 32 * ks + 8 * fq);
                    const bf16x8 second = *(const LAS bf16x8*)(WL + (16 * tbk + fr) * 136 + 32 * ks + 8 * fq);
                    acc = MFMA16(first, second, acc);
                }
                const int rt = 16 * tbk + fr, cc = g * 128 + 16 * w + 4 * fq;
                float u[4]; unpack4(*(const u32x2*)(GU + (size_t)(t0 + rt) * 512 + cc), u);
                const float sbv = sb[g * 128 + rt];
                *(u32x2*)(GU + (size_t)(t0 + rt) * 512 + cc) = pack4(geluf_(u[0]) * (acc[0] + sbv), geluf_(u[1]) * (acc[1] + sbv), geluf_(u[2]) * (acc[2] + sbv), geluf_(u[3]) * (acc[3] + sbv));
            }
            __syncthreads();
        }
        {
            float hc[4][4], pc[4][4], spl[4][4];
#pragma unroll
            for (int nt = 0; nt < 4; ++nt)
#pragma unroll
                for (int j = 0; j < 4; ++j) { hc[nt][j] = 0.f; pc[nt][j] = 1.f; spl[nt][j] = 8.0f * softplus_precise(-lam[64 * w + 16 * nt + 4 * fq + j]); }
#pragma unroll 1
            for (int mt = 0; mt < 8; ++mt) {
                int wz = 64 * w; asm volatile("" : "+v"(wz));
                const int rt = 16 * mt + fr, t = t0 + rt, pos = pos0 + rt;
                bf16x8 xop[2];
#pragma unroll
                for (int ks = 0; ks < 2; ++ks) {
                    const int cc = wz + 32 * ks + 8 * fq; float a8[8];
#pragma unroll
                    for (int j = 0; j < 8; ++j) a8[j] = cb[cc + j];
#pragma unroll
                    for (int jj = 0; jj < 4; ++jj) {
                        if (pos - 3 + jj >= 0) { float x[8]; unpack8(*(const u32x4*)(LX + (size_t)(t - 3 + jj) * 512 + cc), x);
#pragma unroll
                            for (int j = 0; j < 8; ++j) a8[j] += x[j] * cw[jj * 512 + cc + j]; }
                    }
                    u32x4 pk; pk.x = cvt_pk_bf16(a8[0], a8[1]); pk.y = cvt_pk_bf16(a8[2], a8[3]); pk.z = cvt_pk_bf16(a8[4], a8[5]); pk.w = cvt_pk_bf16(a8[6], a8[7]);
                    xop[ks] = __builtin_bit_cast(bf16x8, pk);
                }
#pragma unroll
                for (int nt = 0; nt < 4; ++nt) {
                    f32x4 accA = (f32x4){0.f, 0.f, 0.f, 0.f}, accX = (f32x4){0.f, 0.f, 0.f, 0.f};
#pragma unroll
                    for (int ks = 0; ks < 2; ++ks) {
                        const bf16x8 fa = *(const bf16x8*)(waT + (size_t)(wz + 16 * nt + fr) * 64 + 32 * ks + 8 * fq);
                        const bf16x8 fx = *(const bf16x8*)(wxT + (size_t)(wz + 16 * nt + fr) * 64 + 32 * ks + 8 * fq);
                        accA = MFMA16(fa, xop[ks], accA); accX = MFMA16(fx, xop[ks], accX);
                    }
                    const int cc = wz + 16 * nt + 4 * fq;
                    float xc[4];
#pragma unroll
                    for (int j = 0; j < 4; ++j) xc[j] = cb[cc + j];
#pragma unroll
                    for (int jj = 0; jj < 4; ++jj) {
                        if (pos - 3 + jj >= 0) { float x[4]; unpack4(*(const u32x2*)(LX + (size_t)(t - 3 + jj) * 512 + cc), x);
#pragma unroll
                            for (int j = 0; j < 4; ++j) xc[j] += x[j] * cw[jj * 512 + cc + j]; }
                    }
                    float yv[4]; unpack4(*(const u32x2*)(LY + (size_t)t * 512 + cc), yv);
                    float A[4], Bv[4];
#pragma unroll
                    for (int j = 0; j < 4; ++j) {
                        const float rg = sigmoidf_(accA[j] + ba[cc + j]), ig = sigmoidf_(accX[j] + bx[cc + j]);
                        const float log_a = -rg * spl[nt][j];
                        A[j] = __expf(log_a);
                        Bv[j] = sqrtf(fmaxf((1.0f - A[j]) * (1.0f + A[j]), 0.f)) * (ig * xc[j]);
                    }
#pragma unroll
                    for (int j = 0; j < 4; ++j) {
                        float a = A[j], bq = Bv[j];
                        { const float ap = dppf_old<0x111>(1.f, a), bp = dppf_old<0x111>(0.f, bq); bq = a * bp + bq; a = a * ap; }
                        { const float ap = dppf_old<0x112>(1.f, a), bp = dppf_old<0x112>(0.f, bq); bq = a * bp + bq; a = a * ap; }
                        { const float ap = dppf_old<0x114>(1.f, a), bp = dppf_old<0x114>(0.f, bq); bq = a * bp + bq; a = a * ap; }
                        { const float ap = dppf_old<0x118>(1.f, a), bp = dppf_old<0x118>(0.f, bq); bq = a * bp + bq; a = a * ap; }
                        const float hh = bq + a * hc[nt][j], pp = a * pc[nt][j];
                        A[j] = pp; Bv[j] = hh;
                        hc[nt][j] = __shfl(hh, (lane & 48) | 15); pc[nt][j] = __shfl(pp, (lane & 48) | 15);
                    }
                    const float y0 = geluf_(yv[0]), y1 = geluf_(yv[1]), y2 = geluf_(yv[2]), y3 = geluf_(yv[3]);
                    *(u32x2*)(GV + (size_t)t * 512 + cc) = pack4(y0 * Bv[0], y1 * Bv[1], y2 * Bv[2], y3 * Bv[3]);
                    *(u32x2*)(LY + (size_t)t * 512 + cc) = pack4(y0 * A[0], y1 * A[1], y2 * A[2], y3 * A[3]);
                }
            }
            if (fr == 0) {
#pragma unroll
                for (int nt = 0; nt < 4; ++nt) { const int cc = 64 * w + 16 * nt + 4 * fq;
                    *(f32x4*)(Pend + (size_t)tile * 512 + cc) = (f32x4){pc[nt][0], pc[nt][1], pc[nt][2], pc[nt][3]};
                    *(f32x4*)(Hend + (size_t)tile * 512 + cc) = (f32x4){hc[nt][0], hc[nt][1], hc[nt][2], hc[nt][3]}; }
            }
        }
        __syncthreads();
    }
}

__device__ void post_phase(const Ctx& c, int l) {
    const int tid = c.tid, w = c.wid, fr = c.fr, fq = c.fq;
    {
        LAS float* CARRY = (LAS float*)c.lds;
        const float* Pend = (const float*)(c.ws + WS_LRUS); const float* Hend = Pend + 512 * 512;
        bf16_t* YH = c.wsb(WS_B4); const bf16_t* YP = c.wsb(WS_B6);
        for (int tile = blockIdx.x; tile < T / 128; tile += c.G) {
            const int ci = tile & 63, base = tile - ci; float carry = 0.f;
            {
                int j = 0;
                for (; j + 8 <= ci; j += 8) {
                    float hv[8], pv[8];
#pragma unroll
                    for (int u = 0; u < 8; ++u) { hv[u] = Hend[(size_t)(base + j + u) * 512 + tid]; pv[u] = Pend[(size_t)(base + j + u) * 512 + tid]; }
#pragma unroll
                    for (int u = 0; u < 8; ++u) carry = hv[u] + pv[u] * carry;
                }
                for (; j < ci; ++j) carry = Hend[(size_t)(base + j) * 512 + tid] + Pend[(size_t)(base + j) * 512 + tid] * carry;
            }
            CARRY[tid] = carry;
            __syncthreads();
            if (ci > 0) {
#pragma unroll 4
                for (int i = 0; i < 16; ++i) {
                    const int idx = tid + 512 * i, row = idx >> 6, cc = (idx & 63) * 8; const size_t o = (size_t)(tile * 128 + row) * 512 + cc;
                    float a[8], p[8]; unpack8(*(const u32x4*)(YH + o), a); unpack8(*(const u32x4*)(YP + o), p);
#pragma unroll
                    for (int j = 0; j < 8; ++j) a[j] += p[j] * CARRY[cc + j];
                    u32x4 pk; pk.x = cvt_pk_bf16(a[0], a[1]); pk.y = cvt_pk_bf16(a[2], a[3]); pk.z = cvt_pk_bf16(a[4], a[5]); pk.w = cvt_pk_bf16(a[6], a[7]);
                    *(u32x4*)(YH + o) = pk;
                }
            }
            __syncthreads();
        }
    }
    LAS bf16_t* SG = (LAS bf16_t*)c.lds;
    bf16_t* Rb = c.wsb(WS_B0); const bf16_t* Kb = c.wsb(WS_B1); const bf16_t* Vb = c.wsb(WS_B2); const bf16_t* MISC = c.wsb(WS_B7); const bf16_t* OS = c.wsb(WS_B5);
    const bf16_t* g2T = c.small(l, SM_G2T);
    const float* r_k = c.in[I_RK] + l * 512; const float* gng = c.in[I_GNG] + l * 512; const float* gnb = c.in[I_GNB] + l * 512;
    for (int tile = blockIdx.x; tile < T / 64; tile += c.G) {
        const int t0 = tile * 64;
#pragma unroll
        for (int i = 0; i < 2; ++i) { const int idx = tid + 512 * i, row = idx >> 4, cc = (idx & 15) * 8;
            *(LAS u32x4*)(SG + row * 136 + cc) = *(const u32x4*)(MISC + (size_t)(t0 + row) * 256 + 128 + cc); }
        __syncthreads();
#pragma unroll 1
        for (int mt = 0; mt < 4; ++mt) {
            int wz = 64 * w; asm volatile("" : "+v"(wz));
            const int rt = 16 * mt + fr, t = t0 + rt;
            f32x4 ag[4];
#pragma unroll
            for (int nt = 0; nt < 4; ++nt) {
                ag[nt] = (f32x4){0.f, 0.f, 0.f, 0.f};
#pragma unroll
                for (int ks = 0; ks < 4; ++ks) {
                    const bf16x8 first = *(const bf16x8*)(g2T + (size_t)(wz + 16 * nt + fr) * 128 + 32 * ks + 8 * fq);
                    const bf16x8 second = *(const LAS bf16x8*)(SG + rt * 136 + 32 * ks + 8 * fq);
                    ag[nt] = MFMA16(first, second, ag[nt]);
                }
            }
            float o[4][4], vv[4][4]; float so = 0.f, sbn = 0.f;
#pragma unroll
            for (int nt = 0; nt < 4; ++nt) {
                const int cc = wz + 16 * nt + 4 * fq; const size_t off = (size_t)t * 512 + cc;
                float r[4], k[4];
                unpack4(*(const u32x2*)(OS + off), o[nt]); unpack4(*(const u32x2*)(Rb + off), r); unpack4(*(const u32x2*)(Kb + off), k); unpack4(*(const u32x2*)(Vb + off), vv[nt]);
#pragma unroll
                for (int j = 0; j < 4; ++j) { so += o[nt][j]; sbn += r[j] * k[j] * r_k[cc + j]; }
            }
            so += __shfl_xor(so, 16); so += __shfl_xor(so, 32); sbn += __shfl_xor(sbn, 16); sbn += __shfl_xor(sbn, 32);
            const float mean = so * (1.0f / 64.0f); float q = 0.f;
#pragma unroll
            for (int nt = 0; nt < 4; ++nt)
#pragma unroll
                for (int j = 0; j < 4; ++j) { const float d = o[nt][j] - mean; q += d * d; }
            q += __shfl_xor(q, 16); q += __shfl_xor(q, 32);
            const float rstd = rsqrtf(q * (1.0f / 64.0f) + GN_EPS);
#pragma unroll
            for (int nt = 0; nt < 4; ++nt) {
                const int cc = wz + 16 * nt + 4 * fq; float y[4];
#pragma unroll
                for (int j = 0; j < 4; ++j) y[j] = ((o[nt][j] - mean) * rstd * gng[cc + j] + gnb[cc + j] + sbn * vv[nt][j]) * ag[nt][j];
                *(u32x2*)(Rb + (size_t)t * 512 + cc) = pack4(y[0], y[1], y[2], y[3]);
            }
        }
        __syncthreads();
    }
}

__device__ void merge_phase(const Ctx& c, const float* bias, int first) {
    const u32x4* G = (const u32x4*)c.wsb(WS_B1); const u32x4* P = (const u32x4*)c.wsb(WS_B5); u32x4* M = (u32x4*)c.wsb(WS_LD);
    const size_t n = (size_t)T * DM / 8;
    for (size_t i = (size_t)blockIdx.x * 512 + c.tid; i < n; i += (size_t)c.G * 512) {
        const int col = (int)(i & 127) * 8;
        float g[8], p[8], m[8];
        unpack8(G[i], g); unpack8(P[i], p);
        if (first) {
#pragma unroll
            for (int j = 0; j < 8; ++j) m[j] = 0.f;
        } else unpack8(M[i], m);
        const f32x4 b0 = *(const f32x4*)(bias + col), b1 = *(const f32x4*)(bias + col + 4);
#pragma unroll
        for (int j = 0; j < 4; ++j) { m[j] += sigmoidf_(g[j] + b0[j]) * p[j]; m[4 + j] += sigmoidf_(g[4 + j] + b1[j]) * p[4 + j]; }
        u32x4 w; w.x = cvt_pk_bf16(m[0], m[1]); w.y = cvt_pk_bf16(m[2], m[3]); w.z = cvt_pk_bf16(m[4], m[5]); w.w = cvt_pk_bf16(m[6], m[7]);
        M[i] = w;
    }
}

#define XB_TMO      128
#define XB_XCNT(j)  (256  + 64 * (j))
#define XB_XSUB(j)  (1280 + 64 * (j))
#define XB_XGEN(j)  (2304 + 64 * (j))
#define XB_TOP      3328
#define XB_TOPGEN   3392
#define XCD_BAR_WORDS 3456
#define XB_SPIN_CAP (1u << 18)

__device__ __forceinline__ unsigned xb_ld(unsigned* p)              { return __hip_atomic_load(p, __ATOMIC_RELAXED, __HIP_MEMORY_SCOPE_AGENT); }
__device__ __forceinline__ unsigned xb_add(unsigned* p, unsigned v) { return __hip_atomic_fetch_add(p, v, __ATOMIC_RELAXED, __HIP_MEMORY_SCOPE_AGENT); }
__device__ __forceinline__ unsigned xb_xcc_id() { return (unsigned)__builtin_amdgcn_s_getreg((3 << 11) | 20) & 0xFu; }
#define XB_SPIN(cond, bar) do { unsigned _sp = 0; while (cond) { __builtin_amdgcn_s_sleep(1); \
    if ((++_sp & 255u) == 0u) { if (xb_ld(&(bar)[XB_TMO])) break; if (_sp > XB_SPIN_CAP) { atomicAdd(&(bar)[XB_TMO], 1u); break; } } } } while (0)

struct XcdBarrier {
    unsigned* bar; unsigned x;
    volatile LAS unsigned* st;
};

__device__ __forceinline__ XcdBarrier xcd_barrier_post(unsigned* bar, volatile LAS unsigned* st) {
    XcdBarrier b; b.bar = bar; b.x = xb_xcc_id(); b.st = st;
    if (threadIdx.x == 0) (void)xb_add(&bar[XB_XCNT(b.x)], 1u);
    return b;
}
__device__ __forceinline__ void xcd_barrier_complete(unsigned* bar, unsigned x, unsigned& nloc, unsigned& nx) {
    const unsigned G = gridDim.x * gridDim.y * gridDim.z;
    unsigned sum, cnt, mine, sp = 0u;
    for (;;) {
        sum = 0u; cnt = 0u; mine = 0u;
#pragma unroll
        for (unsigned j = 0; j < 16; ++j) { const unsigned c = xb_ld(&bar[XB_XCNT(j)]); sum += c; cnt += (c > 0u) ? 1u : 0u; mine = (j == x) ? c : mine; }
        if (sum == G) break;
        __builtin_amdgcn_s_sleep(1);
        if ((++sp & 255u) == 0u) { if (xb_ld(&bar[XB_TMO])) break; if (sp > XB_SPIN_CAP) { atomicAdd(&bar[XB_TMO], 1u); break; } }
    }
    nloc = mine > 0u ? mine : 1u; nx = cnt > 0u ? cnt : 1u;
}

__device__ __forceinline__ void xcd_barrier(const XcdBarrier& b) {
    asm volatile("s_waitcnt vmcnt(0)" ::: "memory");
    __syncthreads();
    if (threadIdx.x == 0) {
        unsigned* bar = b.bar;
        __builtin_amdgcn_s_waitcnt(0);
        unsigned nloc = b.st[0], nx = b.st[1];
        if (nloc == 0u) { xcd_barrier_complete(bar, b.x, nloc, nx); b.st[0] = nloc; b.st[1] = nx; }
        const unsigned old = xb_add(&bar[XB_XSUB(b.x)], 1u);
        const unsigned gen = old / nloc;
        if (old + 1u == (gen + 1u) * nloc) {
            __builtin_amdgcn_fence(__ATOMIC_RELEASE, "agent");
            asm volatile("s_waitcnt vmcnt(0)" ::: "memory");
            const unsigned og = xb_add(&bar[XB_TOP], 1u);
            const unsigned tg = og / nx;
            if (og + 1u == (tg + 1u) * nx) xb_add(&bar[XB_TOPGEN], 1u);
            else XB_SPIN(xb_ld(&bar[XB_TOPGEN]) == tg, bar);
            __builtin_amdgcn_fence(__ATOMIC_ACQUIRE, "agent");
            xb_add(&bar[XB_XGEN(b.x)], 1u);
            asm volatile("s_waitcnt vmcnt(0)" ::: "memory");
        } else {
            XB_SPIN(xb_ld(&bar[XB_XGEN(b.x)]) == gen, bar);
            __builtin_amdgcn_fence(__ATOMIC_ACQUIRE, "agent");
            asm volatile("s_waitcnt vmcnt(0)" ::: "memory");
        }
    }
    __syncthreads();
}


constexpr int NPL = 13, NPH = 1 + 2 * NPL;
__global__ void __launch_bounds__(512, 2) fwd_kernel(Args a) {
    __shared__ __attribute__((aligned(16))) unsigned char shm[LDS_BYTES];
    cg::grid_group grid = cg::this_grid();
    Ctx c; c.in = a.in; c.X = a.out; c.ws = a.ws; c.lds = shm; c.tid = threadIdx.x; c.lane = c.tid & 63; c.wid = __builtin_amdgcn_readfirstlane(c.tid >> 6); c.fr = c.lane & 15; c.fq = c.lane >> 4; c.G = gridDim.x;
    PG8_LAS unsigned char* lds3 = (PG8_LAS unsigned char*)shm;
    volatile LAS unsigned* xb_st = (volatile LAS unsigned*)((LAS unsigned char*)shm + LDS_BYTES - 16);
    if (threadIdx.x < 4) xb_st[threadIdx.x] = 0u;
    __syncthreads();
    XcdBarrier xbar; xbar.bar = (unsigned*)(a.ws + WS_XBAR); xbar.x = 0; xbar.st = xb_st;
    if (a.coop != 0) xbar = xcd_barrier_post((unsigned*)(a.ws + WS_XBAR), xb_st);
    const int lo = a.ph_lo, hi = a.ph_hi; const bool coop = a.coop != 0;
    int ph = 0;
#define PH_BEGIN if (ph >= lo && ph < hi) { c.refresh();
#define PH_END if (coop && ph + 1 < hi) { if (ph == 0) grid.sync(); else xcd_barrier(xbar); } } ++ph;
    PH_BEGIN p0_phase(c); PH_END
#pragma unroll 1
    for (int l = 0; l < 2; ++l) {
#pragma unroll 1
        for (int f = 0; f < 2; ++f) {
            const int lf = l * 2 + f;
            PH_BEGIN
                pg8::Gemm g{c.wsb(WS_XB), c.wsb(WS_W13) + (size_t)lf * 5632 * 1024, T, 5632, 1024}; pg8::StaticOrder S; S.init(T, 5632, c.G, (int)blockIdx.x);
                pg8::EpiSwiglu E{c.wsb(WS_R)}; pg8::gemm_phase(lds3, g, S, E);
            PH_END
            PH_BEGIN
                pg8::Gemm g{c.wsb(WS_R), c.wsb(WS_W2) + (size_t)lf * 1024 * FF, T, 1024, FF}; pg8::StaticOrder S; S.init(T, 1024, c.G, (int)blockIdx.x);
                const int kprev = l * 3 + (f == 0 ? 0 : 2) - 1; const bool first = kprev < 0;
                pg8::EpiResF32 E{c.X, first ? a.in[I_X] : (const float*)c.X, (const f32x2*)(a.ws + WS_STATS), first ? (const float*)(a.ws + WS_IDENT) : a.in[I_LNG] + (size_t)kprev * 1024, first ? (const float*)(a.ws + WS_IDENT) + 1024 : a.in[I_LNB] + (size_t)kprev * 1024, ALPHA, 0.5f}; pg8::gemm_phase(lds3, g, S, E);
            PH_END
            PH_BEGIN ln_phase(c, a.in[I_LNG] + (size_t)(l * 3 + (f == 0 ? 0 : 2)) * 1024, a.in[I_LNB] + (size_t)(l * 3 + (f == 0 ? 0 : 2)) * 1024, l == 1 && f == 1); PH_END
            if (f == 0) {
                PH_BEGIN
                    pg8::Gemm g{c.wsb(WS_XB), c.wsb(WS_WIN) + (size_t)l * 6912 * 1024, T, 3840, 1024}; pg8::StaticOrder S; S.init(T, 3840, c.G, (int)blockIdx.x);
                    pg8::EpiZ E{c.wsb(WS_R), c.wsb(WS_HALO)}; pg8::gemm_phase(lds3, g, S, E);
                PH_END
                PH_BEGIN if (l == 0) prep_phase<0>(c, 0); else prep_phase<1>(c, 1);
                    __syncthreads(); gmlp_lru_phase(c, l, 0);
                PH_END
                PH_BEGIN scan_phase(c);
#ifdef PROBE_SCAN2
                    __syncthreads(); scan_phase(c);
#endif
                PH_END
                PH_BEGIN post_phase(c, l); PH_END
                PH_BEGIN
#pragma unroll 1
                    for (int i = 0; i < 3; ++i) {
                        { pg8::Gemm g{c.wsb(WS_XB), c.wsb(WS_WIN) + (size_t)l * 6912 * 1024 + (size_t)(3840 + 1024 * i) * 1024, T, 1024, 1024}; pg8::StaticOrder S; S.init(T, 1024, c.G, (int)blockIdx.x);
                          pg8::EpiBf E{c.wsb(WS_B1), 1024}; pg8::gemm_phase(lds3, g, S, E); }
                        { const bf16_t* oi = c.wsb(i == 0 ? WS_B0 : (i == 1 ? WS_B3 : WS_B4));
                          pg8::Gemm g{oi, c.wsb(WS_PB) + (size_t)(l * 3 + i) * 1024 * 512, T, 1024, 512}; pg8::StaticOrder S; S.init(T, 1024, c.G, (int)blockIdx.x);
                          pg8::EpiMergeF E{c.wsb(WS_B1), c.wsb(WS_LD), a.in[I_GATEB] + (size_t)(l * 3 + i) * 1024, i == 0 ? 1 : 0}; pg8::gemm_phase(lds3, g, S, E); }
                    }
                PH_END
                PH_BEGIN
                    pg8::Gemm g{c.wsb(WS_LD), c.wsb(WS_WO) + (size_t)l * 1024 * 1024, T, 1024, 1024}; pg8::StaticOrder S; S.init(T, 1024, c.G, (int)blockIdx.x);
                    pg8::EpiResF32 E{c.X, (const float*)c.X, (const f32x2*)(a.ws + WS_STATS), a.in[I_LNG] + (size_t)(l * 3) * 1024, a.in[I_LNB] + (size_t)(l * 3) * 1024, ALPHA, 1.0f}; pg8::gemm_phase(lds3, g, S, E);
                PH_END
                PH_BEGIN ln_phase(c, a.in[I_LNG] + (size_t)(l * 3 + 1) * 1024, a.in[I_LNB] + (size_t)(l * 3 + 1) * 1024, false); PH_END
            }
        }
    }
#undef PH_BEGIN
#undef PH_END
}

__global__ void digest_kernel(const unsigned short* src, float* out) {
    for (size_t i = (size_t)blockIdx.x * 256 + threadIdx.x; i < (size_t)T * DM; i += (size_t)gridDim.x * 256) out[i] = __uint_as_float(((unsigned)src[i]) << 16);
}
extern "C" void kernel_launch(void* const* d_in, const int* in_sizes, int n_in, void* d_out, int out_size, void* d_ws, size_t ws_size, hipStream_t stream) {
    static int grid = 0;
    if (grid == 0) {
        if (n_in != 35 || out_size != T * DM || ws_size < WS_END) { fprintf(stderr, "kernel_launch: unexpected shapes (n_in %d out %d ws %zu need %zu)\n", n_in, out_size, ws_size, (size_t)WS_END); grid = -1; return; }
        int dev = 0, cus = 0, per_cu = 0;
        (void)hipGetDevice(&dev); (void)hipDeviceGetAttribute(&cus, hipDeviceAttributeMultiprocessorCount, dev);
        if (hipOccupancyMaxActiveBlocksPerMultiprocessor(&per_cu, (const void*)fwd_kernel, 512, 0) != hipSuccess || per_cu < 1) { fprintf(stderr, "kernel_launch: occupancy query says %d\n", per_cu); per_cu = 1; }
        (void)hipGetLastError();
        grid = cus;
        if (grid < 65) { fprintf(stderr, "kernel_launch: grid %d too small\n", grid); grid = -1; return; }
    }
    if (grid < 0) return;
    Args a{};
    for (int i = 0; i < 35; ++i) a.in[i] = (const float*)d_in[i];
    a.out = (float*)d_out; a.ws = (unsigned char*)d_ws;
#if ONE_LAUNCH
    if (hipMemsetAsync((char*)d_ws + WS_XBAR, 0, XCD_BAR_WORDS * sizeof(unsigned), stream) != hipSuccess) fprintf(stderr, "kernel_launch: memset of barrier words failed\n");
    a.ph_lo = 0; a.ph_hi = NPH; a.coop = 1; a.pad = 0;
    void* args[] = {&a};
    hipError_t e = hipLaunchCooperativeKernel((const void*)fwd_kernel, dim3(grid), dim3(512), args, 0, stream);
    if (e != hipSuccess) fprintf(stderr, "cooperative launch failed: %s (grid %d)\n", hipGetErrorString(e), grid);
#else
    for (int p = 0; p < NPH && p <= STOP_AFTER; ++p) {
        a.ph_lo = p; a.ph_hi = p + 1; a.coop = 0; a.pad = 0;
        hipLaunchKernelGGL(fwd_kernel, dim3(grid), dim3(512), 0, stream, a);
    }
    if (DIGEST_OFF_MIB > 0) hipLaunchKernelGGL(digest_kernel, dim3(2048), dim3(256), 0, stream, (const unsigned short*)((const char*)d_ws + (size_t)DIGEST_OFF_MIB * MiB), (float*)d_out);
#endif
}
```

```cpp
#include <hip/hip_runtime.h>
#include <hip/hip_cooperative_groups.h>
#include <cstdio>
namespace cg = cooperative_groups;

#ifndef STOP_AFTER
#define STOP_AFTER 1000
#endif
#ifndef DIGEST_OFF_MIB
#define DIGEST_OFF_MIB 0
#endif
#ifndef ONE_LAUNCH
#define ONE_LAUNCH 1
#endif

#define LAS __attribute__((address_space(3)))
typedef unsigned short bf16_t;
typedef short bf16x8 __attribute__((ext_vector_type(8)));
typedef short bf16x4 __attribute__((ext_vector_type(4)));
typedef float f32x4 __attribute__((ext_vector_type(4)));
typedef float f32x2 __attribute__((ext_vector_type(2)));
typedef unsigned u32x4 __attribute__((ext_vector_type(4)));
typedef unsigned u32x2 __attribute__((ext_vector_type(2)));

constexpr int T = 65536, DM = 1024, FF = 2816, SEQ = 8192;
constexpr float ALPHA = 1.4142135623730951f;
constexpr float LN_EPS = 1e-5f, GN_EPS = 64e-5f;
constexpr int LDS_BYTES = 136 * 1024;
constexpr size_t MiB = 1ull << 20;
constexpr size_t WS_STATS = 6 * MiB + 1280 * 1024  , WS_IDENT = 6 * MiB + 1792 * 1024  , WS_XBAR = 3840 * 1024, WS_HALO = 0, WS_LRUS = 4 * MiB, WS_SMALL = 6 * MiB, WS_W13 = 8 * MiB, WS_W2 = 52 * MiB, WS_WIN = 74 * MiB, WS_PB = 101 * MiB, WS_WO = 107 * MiB,
                 WS_XB = 112 * MiB, WS_VF = 240 * MiB, WS_R = 304 * MiB;
constexpr size_t BLK = 64 * MiB;
constexpr size_t WS_B0 = WS_R, WS_B1 = WS_R + BLK, WS_B2 = WS_R + 2 * BLK, WS_B3 = WS_R + 3 * BLK, WS_B4 = WS_R + 4 * BLK, WS_B5 = WS_R + 5 * BLK, WS_B6 = WS_R + 6 * BLK,
                 WS_B7 = WS_R + 7 * BLK, WS_LD = WS_B7 + 32 * MiB, WS_KK = WS_LD + BLK, WS_BB = WS_KK + BLK, WS_END = WS_BB + BLK;
constexpr int SM_W2T = 0, SM_A2T = 32768, SM_G2T = 65536, SM_WAT = 131072, SM_WXT = 163840, SM_WM = 196608, SM_L = 262144, SM_V1T = 2 * SM_L, SM_V2T = SM_V1T + 16384;

__device__ __forceinline__ float bf2f(bf16_t h) { return __uint_as_float(((unsigned)h) << 16); }
__device__ __forceinline__ float bfs2f(short h) { return __uint_as_float(((unsigned)(unsigned short)h) << 16); }
__device__ __forceinline__ bf16_t f2bf(float f) { unsigned u = __float_as_uint(f); u += 0x7FFFu + ((u >> 16) & 1u); return (bf16_t)(u >> 16); }
typedef __bf16 bf16x2_t __attribute__((ext_vector_type(2)));
__device__ __forceinline__ unsigned cvt_pk_bf16(float lo, float hi) { const f32x2 v = {lo, hi}; const bf16x2_t b = __builtin_convertvector(v, bf16x2_t); return __builtin_bit_cast(unsigned, b); }
__device__ __forceinline__ u32x2 pack4(float a, float b, float c, float d) { u32x2 r; r.x = cvt_pk_bf16(a, b); r.y = cvt_pk_bf16(c, d); return r; }
__device__ __forceinline__ void unpack4(u32x2 p, float* o) { o[0] = __uint_as_float(p.x << 16); o[1] = __uint_as_float(p.x & 0xFFFF0000u); o[2] = __uint_as_float(p.y << 16); o[3] = __uint_as_float(p.y & 0xFFFF0000u); }
__device__ __forceinline__ void unpack8(u32x4 p, float* o) { unpack4((u32x2){p.x, p.y}, o); unpack4((u32x2){p.z, p.w}, o + 4); }
__device__ __forceinline__ float sigmoidf_(float x) { return __builtin_amdgcn_rcpf(1.0f + __expf(-x)); }
__device__ __forceinline__ float siluf_(float x) { return x * sigmoidf_(x); }
__device__ __forceinline__ float tanhf_(float u) { return 1.0f - 2.0f * __builtin_amdgcn_rcpf(1.0f + __expf(2.0f * u)); }
__device__ __forceinline__ float geluf_(float x) { return 0.5f * x * (1.0f + tanhf_(0.7978845608028654f * (x + 0.044715f * x * x * x))); }
__device__ __forceinline__ float softplusf_(float x) { return fmaxf(x, 0.f) + __logf(1.0f + __expf(-fabsf(x))); }
__device__ __forceinline__ float softplus_precise(float x) { return fmaxf(x, 0.f) + log1pf(__expf(-fabsf(x))); }
template <int CTRL> __device__ __forceinline__ float dppf(float v) { return __int_as_float(__builtin_amdgcn_update_dpp(0, __float_as_int(v), CTRL, 0xF, 0xF, true)); }
template <int CTRL> __device__ __forceinline__ float dppf_old(float old, float v) { return __int_as_float(__builtin_amdgcn_update_dpp(__float_as_int(old), __float_as_int(v), CTRL, 0xF, 0xF, false)); }
__device__ __forceinline__ float wave_sum(float v) {
#pragma unroll
    for (int o = 1; o < 64; o <<= 1) v += __shfl_xor(v, o);
    return v;
}
#define MFMA16(a, b, c) __builtin_amdgcn_mfma_f32_16x16x32_bf16((a), (b), (c), 0, 0, 0)

namespace pg8 {
#define PG8_LAS __attribute__((address_space(3)))
constexpr int BM = 256, BK = 64, HALF = 128, HTB = HALF * BK * 2, STAGE_BYTES = 8 * HTB, NXCD = 8, WGM = 8;
__host__ __device__ __forceinline__ int lds_byte(int r, int c) { const int st = (r >> 4) * 2 + (c >> 5), rr = r & 15, cc = c & 31, ob = rr * 64 + cc * 2; return st * 1024 + (ob ^ (((ob >> 9) & 1) << 5)); }
__host__ __device__ __forceinline__ void stage_rc(int b, int& R, int& C) { const int st = b / 1024, sb = b % 1024, swz = sb ^ (((sb >> 9) & 1) << 5); R = (st >> 1) * 16 + swz / 64; C = (st & 1) * 32 + (swz % 64) / 2; }
__host__ __device__ __forceinline__ int perm32(int rho) { const int n = rho >> 4, i = rho & 15; return 8 * (i >> 2) + 4 * n + (i & 3); }
struct Unit { int pm, pn; };
struct Gemm { const bf16_t* A; const bf16_t* Bt; int M, N, K; };
struct StaticOrder {
    int nM, nN, nwg, G, c;
    __host__ __device__ void init(int M, int N, int G_, int c_) { nM = M / BM; nN = N / BM; nwg = nM * nN; G = G_; c = c_; }
    __host__ __device__ bool next(int i, Unit& u) const {
        const long L = (long)i * G + c; if (L >= nwg) return false;
        int wgid = (int)L; { const int q = nwg / NXCD, r = nwg % NXCD, xcd = wgid % NXCD, off = wgid / NXCD; wgid = (xcd < r ? xcd * (q + 1) : r * (q + 1) + (xcd - r) * q) + off; }
        const int nig = WGM * nN, gid = wgid / nig, fm = gid * WGM, gsz = (nM - fm) < WGM ? (nM - fm) : WGM;
        u.pm = fm + ((wgid % nig) % gsz); u.pn = (wgid % nig) / gsz; return true;
    }
    __device__ __forceinline__ void a_ready(const Unit&) const {}
    __device__ __forceinline__ void done(const Unit&) const {}
};

struct EpiSwiglu {
    static constexpr bool PERM = true, AFTER_DRAIN = false;
    bf16_t* H;
    __device__ __forceinline__ void operator()(const f32x4 (&acc)[2][2][4][2], const Unit& u, int wr, int wc, int fr, int fq) const {
        const int row0 = u.pm * BM + wr * 64 + fr, col0 = u.pn * 128 + wc * 32 + 8 * fq;
#pragma unroll
        for (int ai = 0; ai < 2; ++ai)
#pragma unroll
            for (int m = 0; m < 4; ++m) {
                bf16_t* rowp = H + (size_t)(row0 + ai * HALF + m * 16) * FF + col0;
                const f32x4 a0 = acc[ai][0][m][0], a1 = acc[ai][0][m][1], b0 = acc[ai][1][m][0], b1 = acc[ai][1][m][1];
                u32x4 w;
                w.x = cvt_pk_bf16(siluf_(a0[0]) * b0[0], siluf_(a0[1]) * b0[1]); w.y = cvt_pk_bf16(siluf_(a0[2]) * b0[2], siluf_(a0[3]) * b0[3]);
                w.z = cvt_pk_bf16(siluf_(a1[0]) * b1[0], siluf_(a1[1]) * b1[1]); w.w = cvt_pk_bf16(siluf_(a1[2]) * b1[2], siluf_(a1[3]) * b1[3]);
                *(u32x4*)rowp = w;
            }
    }
};
struct EpiResF32 {
    static constexpr bool PERM = false, AFTER_DRAIN = false;
    float* X; const float* U; const f32x2* stats; const float* g; const float* b; float alpha, scale;
    __device__ __forceinline__ void operator()(const f32x4 (&acc)[2][2][4][2], const Unit& u, int wr, int wc, int fr, int fq) const {
        const int row0 = u.pm * BM + wr * 64 + fr, col0 = u.pn * BM + wc * 32 + 4 * fq;
        f32x4 ga[2][2], ba[2][2];
#pragma unroll
        for (int bj = 0; bj < 2; ++bj)
#pragma unroll
            for (int n = 0; n < 2; ++n) { ga[bj][n] = *(const f32x4*)(g + col0 + bj * HALF + n * 16) * alpha; ba[bj][n] = *(const f32x4*)(b + col0 + bj * HALF + n * 16) * alpha; }
#pragma unroll
        for (int ai = 0; ai < 2; ++ai)
#pragma unroll
            for (int m = 0; m < 4; ++m) { const int row = row0 + ai * HALF + m * 16; const size_t ro = (size_t)row * DM + col0;
                const f32x2 st = stats[row]; const float rs = st.y, nm = -st.x * st.y;
#pragma unroll
                for (int bj = 0; bj < 2; ++bj)
#pragma unroll
                    for (int n = 0; n < 2; ++n) { const size_t o = ro + bj * HALF + n * 16; const f32x4 t = *(const f32x4*)(U + o) * rs + nm;
                        *(f32x4*)(X + o) = (t * ga[bj][n] + ba[bj][n]) + acc[ai][bj][m][n] * scale; } }
    }
};
struct EpiZ {
    static constexpr bool PERM = true, AFTER_DRAIN = false;
    bf16_t* Z; bf16_t* halo;
    __device__ __forceinline__ void operator()(const f32x4 (&acc)[2][2][4][2], const Unit& u, int wr, int wc, int fr, int fq) const {
        const int row0 = u.pm * BM + wr * 64 + fr; const int pn = u.pn;
        bf16_t* base; int ldc, colt;
        if (pn < 14) { base = Z + (size_t)(pn >> 1) * T * 512; ldc = 512; colt = (pn & 1) * 256; } else { base = Z + (size_t)7 * T * 512; ldc = 256; colt = 0; }
        const bool dohalo = (pn < 6) || (pn == 14); const int hc = (pn < 6 ? pn * 256 : 1536) + wc * 32 + 8 * fq;
        const int col0 = colt + wc * 32 + 8 * fq;
#pragma unroll
        for (int ai = 0; ai < 2; ++ai)
#pragma unroll
            for (int m = 0; m < 4; ++m) { const int row = row0 + ai * HALF + m * 16; bf16_t* rowp = base + (size_t)row * ldc + col0;
#pragma unroll
                for (int bj = 0; bj < 2; ++bj) { const f32x4 v0 = acc[ai][bj][m][0], v1 = acc[ai][bj][m][1];
                    u32x4 w; w.x = cvt_pk_bf16(v0[0], v0[1]); w.y = cvt_pk_bf16(v0[2], v0[3]); w.z = cvt_pk_bf16(v1[0], v1[1]); w.w = cvt_pk_bf16(v1[2], v1[3]);
                    *(u32x4*)(rowp + bj * HALF) = w;
                    if (dohalo && (row & 63) == 63) *(u32x4*)(halo + (size_t)(row >> 6) * 1792 + hc + bj * HALF) = w; } }
    }
};
struct EpiBf {
    static constexpr bool PERM = true, AFTER_DRAIN = false;
    bf16_t* O; int ldc;
    __device__ __forceinline__ void operator()(const f32x4 (&acc)[2][2][4][2], const Unit& u, int wr, int wc, int fr, int fq) const {
        const int row0 = u.pm * BM + wr * 64 + fr, col0 = u.pn * BM + wc * 32 + 8 * fq;
#pragma unroll
        for (int ai = 0; ai < 2; ++ai)
#pragma unroll
            for (int m = 0; m < 4; ++m) { bf16_t* rowp = O + (size_t)(row0 + ai * HALF + m * 16) * ldc + col0;
#pragma unroll
                for (int bj = 0; bj < 2; ++bj) { const f32x4 v0 = acc[ai][bj][m][0], v1 = acc[ai][bj][m][1];
                    u32x4 w; w.x = cvt_pk_bf16(v0[0], v0[1]); w.y = cvt_pk_bf16(v0[2], v0[3]); w.z = cvt_pk_bf16(v1[0], v1[1]); w.w = cvt_pk_bf16(v1[2], v1[3]);
                    *(u32x4*)(rowp + bj * HALF) = w; } }
    }
};

struct EpiMergeF {
    static constexpr bool PERM = true, AFTER_DRAIN = false;
    const bf16_t* G; bf16_t* Mg; const float* bias; int first;
    __device__ __forceinline__ void operator()(const f32x4 (&acc)[2][2][4][2], const Unit& u, int wr, int wc, int fr, int fq) const {
        const int row0 = u.pm * BM + wr * 64 + fr, col0 = u.pn * BM + wc * 32 + 8 * fq;
#pragma unroll
        for (int bj = 0; bj < 2; ++bj) {
            const f32x4 b0 = *(const f32x4*)(bias + col0 + bj * HALF), b1 = *(const f32x4*)(bias + col0 + bj * HALF + 4);
#pragma unroll
            for (int ai = 0; ai < 2; ++ai)
#pragma unroll
                for (int m = 0; m < 4; ++m) { const size_t off = (size_t)(row0 + ai * HALF + m * 16) * DM + col0 + bj * HALF;
                    const f32x4 v0 = acc[ai][bj][m][0], v1 = acc[ai][bj][m][1];
                    float g[8], o[8]; unpack8(*(const u32x4*)(G + off), g);
                    if (first) {
#pragma unroll
                        for (int j = 0; j < 8; ++j) o[j] = 0.f;
                    } else unpack8(*(const u32x4*)(Mg + off), o);
#pragma unroll
                    for (int j = 0; j < 4; ++j) { o[j] += sigmoidf_(g[j] + b0[j]) * v0[j]; o[4 + j] += sigmoidf_(g[4 + j] + b1[j]) * v1[j]; }
                    u32x4 w; w.x = cvt_pk_bf16(o[0], o[1]); w.y = cvt_pk_bf16(o[2], o[3]); w.z = cvt_pk_bf16(o[4], o[5]); w.w = cvt_pk_bf16(o[6], o[7]);
                    *(u32x4*)(Mg + off) = w; }
        }
    }
};

template <class Epi, class Sched, bool ALIGN_EPI = true, bool SP2 = true>
__device__ __forceinline__ void gemm_phase(PG8_LAS unsigned char* lds, const Gemm g, const Sched& S, const Epi& E) {
    int tid_ = threadIdx.x; asm volatile("" : "+v"(tid_));
    const int tid = tid_, wid = __builtin_amdgcn_readfirstlane(tid >> 6), lane = tid & 63, wr = wid >> 2, wc = wid & 3, fr = lane & 15, fq = lane >> 4;
    const int K = g.K, nt = K / BK;
    unsigned voffA[2], voffB[2];
#pragma unroll
    for (int i = 0; i < 2; ++i) { int R, C; stage_rc(tid * 16 + i * 8192, R, C); const int Rb = Epi::PERM ? ((R & ~31) + perm32(R & 31)) : R;
        voffA[i] = (unsigned)(R * K + C) * 2u; voffB[i] = (unsigned)(Rb * K + C) * 2u; }
    const size_t kstep = (size_t)(BK * 2);
    const size_t hstep = (size_t)HALF * K * 2;
    const size_t tstep = 2 * hstep;
    const unsigned ldsw = (unsigned)wid * 1024u;
    const int aoff = lds_byte(wr * 64 + fr, fq * 8), boff = lds_byte(wc * 32 + fr, fq * 8);
#define PG8_SA(b, h) (((b) * 2 + (h)) * HTB)
#define PG8_SB(b, h) ((4 + (b) * 2 + (h)) * HTB)
#define PG8_STAGE(bufoff, gbase, voff) do { _Pragma("unroll") for (int _i = 0; _i < 2; ++_i) \
        __builtin_amdgcn_global_load_lds((const unsigned*)((const char*)(gbase) + (voff)[_i]), (PG8_LAS unsigned*)(lds + (bufoff) + ldsw + _i * 8192), 16, 0, 0); } while (0)
#define PG8_LDA(dst, b, h) do { _Pragma("unroll") for (int m = 0; m < 4; ++m) _Pragma("unroll") for (int k = 0; k < 2; ++k) dst[m][k] = *(const PG8_LAS bf16x8*)(lds + PG8_SA(b, h) + aoff + m * 2048 + k * 1024); } while (0)
#define PG8_LDB(dst, b, h) do { _Pragma("unroll") for (int n = 0; n < 2; ++n) _Pragma("unroll") for (int k = 0; k < 2; ++k) dst[n][k] = *(const PG8_LAS bf16x8*)(lds + PG8_SB(b, h) + boff + n * 2048 + k * 1024); } while (0)
#define PG8_MMA(ai, bj, At, Bt) do { __builtin_amdgcn_s_setprio(1); _Pragma("unroll") for (int m = 0; m < 4; ++m) _Pragma("unroll") for (int n = 0; n < 2; ++n) _Pragma("unroll") for (int k = 0; k < 2; ++k) \
        acc[ai][bj][m][n] = __builtin_amdgcn_mfma_f32_16x16x32_bf16(Bt[n][k], At[m][k], acc[ai][bj][m][n], 0, 0, 0); __builtin_amdgcn_s_setprio(0); } while (0)
#define PG8_WAIT_V(n) asm volatile("s_waitcnt vmcnt(" #n ")" ::: "memory")
#define PG8_WAIT_L(n) asm volatile("s_waitcnt lgkmcnt(" #n ")" ::: "memory")
#define PG8_BAR __builtin_amdgcn_s_barrier()
#define PG8_SCHED __builtin_amdgcn_sched_barrier(0)
    Unit cur, nxt; int ui = 0;
    if (!S.next(0, cur)) return;
    f32x4 acc[2][2][4][2];
#pragma unroll
    for (int a = 0; a < 2; ++a)
#pragma unroll
        for (int b = 0; b < 2; ++b)
#pragma unroll
            for (int m = 0; m < 4; ++m)
#pragma unroll
                for (int n = 0; n < 2; ++n) acc[a][b][m][n] = (f32x4){0.f, 0.f, 0.f, 0.f};
    bf16x8 At[4][2], B0[2][2], B1[2][2];
    const char* cA = (const char*)g.A + (size_t)cur.pm * tstep; const char* cB = (const char*)g.Bt + (size_t)cur.pn * tstep;
    S.a_ready(cur);
    if constexpr (SP2) {
        PG8_STAGE(PG8_SB(0, 0), cB, voffB); PG8_STAGE(PG8_SB(0, 1), cB + hstep, voffB); PG8_STAGE(PG8_SA(0, 0), cA, voffA); PG8_STAGE(PG8_SA(0, 1), cA + hstep, voffA);
        if (wr == 1) PG8_BAR;
        PG8_WAIT_V(2); PG8_BAR;
        PG8_STAGE(PG8_SB(1, 0), cB + kstep, voffB); PG8_STAGE(PG8_SA(1, 0), cA + kstep, voffA); PG8_STAGE(PG8_SB(1, 1), cB + hstep + kstep, voffB);
        PG8_WAIT_V(6); PG8_BAR;
    } else {
        PG8_STAGE(PG8_SB(0, 0), cB, voffB); PG8_STAGE(PG8_SA(0, 0), cA, voffA); PG8_STAGE(PG8_SB(0, 1), cB + hstep, voffB); PG8_STAGE(PG8_SA(0, 1), cA + hstep, voffA);
        if (wr == 1) PG8_BAR;
        PG8_WAIT_V(4); PG8_BAR;
        PG8_STAGE(PG8_SB(1, 0), cB + kstep, voffB); PG8_STAGE(PG8_SA(1, 0), cA + kstep, voffA); PG8_STAGE(PG8_SB(1, 1), cB + hstep + kstep, voffB);
        PG8_WAIT_V(6); PG8_BAR;
    }
    for (;;) {
        const bool has_next = S.next(ui + 1, nxt);
        const char* nA = has_next ? (const char*)g.A + (size_t)nxt.pm * tstep : cA; const char* nB = has_next ? (const char*)g.Bt + (size_t)nxt.pn * tstep : cB;
        for (int t = 0; t < nt; t += 2) {
            const bool last = (t == nt - 2);
            const char* a1 = cA + (size_t)(t + 1) * kstep;
            const char* a2 = last ? nA : cA + (size_t)(t + 2) * kstep; const char* b2 = last ? nB : cB + (size_t)(t + 2) * kstep;
            const char* a3 = a2 + kstep; const char* b3 = b2 + kstep;
            if (last && has_next) S.a_ready(nxt);
            if constexpr (SP2) {
            PG8_LDB(B0, 0, 0); PG8_LDB(B1, 0, 1); PG8_SCHED; PG8_LDA(At, 0, 0); PG8_STAGE(PG8_SA(1, 1), a1 + hstep, voffA);
            PG8_WAIT_V(8); PG8_WAIT_L(0); PG8_BAR; PG8_MMA(0, 0, At, B0); PG8_MMA(0, 1, At, B1); PG8_BAR; PG8_SCHED;
            PG8_LDA(At, 0, 1); PG8_STAGE(PG8_SB(0, 0), b2, voffB); PG8_STAGE(PG8_SB(0, 1), b2 + hstep, voffB); PG8_STAGE(PG8_SA(0, 0), a2, voffA);
            PG8_WAIT_V(8); PG8_WAIT_L(0); PG8_BAR; PG8_MMA(1, 0, At, B0); PG8_MMA(1, 1, At, B1); PG8_BAR; PG8_SCHED;
            PG8_LDB(B0, 1, 0); PG8_LDB(B1, 1, 1); PG8_SCHED; PG8_LDA(At, 1, 0); PG8_STAGE(PG8_SA(0, 1), a2 + hstep, voffA);
            PG8_WAIT_V(8); PG8_WAIT_L(0); PG8_BAR; PG8_MMA(0, 0, At, B0); PG8_MMA(0, 1, At, B1); PG8_BAR; PG8_SCHED;
            PG8_LDA(At, 1, 1); PG8_STAGE(PG8_SB(1, 0), b3, voffB); PG8_STAGE(PG8_SB(1, 1), b3 + hstep, voffB); PG8_STAGE(PG8_SA(1, 0), a3, voffA);
            PG8_WAIT_V(8); PG8_WAIT_L(0); PG8_BAR; PG8_MMA(1, 0, At, B0); PG8_MMA(1, 1, At, B1); PG8_BAR; PG8_SCHED;
            } else {
            PG8_LDB(B0, 0, 0); PG8_SCHED; PG8_LDA(At, 0, 0); PG8_STAGE(PG8_SA(1, 1), a1 + hstep, voffA);
            PG8_WAIT_L(8); PG8_BAR; PG8_WAIT_L(0); PG8_MMA(0, 0, At, B0); PG8_BAR; PG8_SCHED;
            PG8_LDB(B1, 0, 1); PG8_STAGE(PG8_SB(0, 0), b2, voffB);
            PG8_BAR; PG8_WAIT_L(0); PG8_MMA(0, 1, At, B1); PG8_BAR;
            PG8_LDA(At, 0, 1); PG8_STAGE(PG8_SA(0, 0), a2, voffA);
            PG8_BAR; PG8_WAIT_L(0); PG8_MMA(1, 0, At, B0); PG8_BAR; PG8_SCHED;
            PG8_STAGE(PG8_SB(0, 1), b2 + hstep, voffB);
            PG8_WAIT_V(6); PG8_BAR; PG8_MMA(1, 1, At, B1); PG8_BAR;
            PG8_LDB(B0, 1, 0); PG8_SCHED; PG8_LDA(At, 1, 0); PG8_STAGE(PG8_SA(0, 1), a2 + hstep, voffA);
            PG8_WAIT_L(8); PG8_BAR; PG8_WAIT_L(0); PG8_MMA(0, 0, At, B0); PG8_BAR; PG8_SCHED;
            PG8_LDB(B1, 1, 1); PG8_STAGE(PG8_SB(1, 0), b3, voffB);
            PG8_BAR; PG8_WAIT_L(0); PG8_MMA(0, 1, At, B1); PG8_BAR;
            PG8_LDA(At, 1, 1); PG8_STAGE(PG8_SA(1, 0), a3, voffA);
            PG8_BAR; PG8_WAIT_L(0); PG8_MMA(1, 0, At, B0); PG8_BAR; PG8_SCHED;
            PG8_STAGE(PG8_SB(1, 1), b3 + hstep, voffB);
            PG8_WAIT_V(6); PG8_BAR; PG8_MMA(1, 1, At, B1); PG8_BAR;
            }
        }
        if constexpr (ALIGN_EPI) { if (wr == 0) PG8_BAR; }
        if constexpr (!Epi::AFTER_DRAIN) { E(acc, cur, wr, wc, fr, fq); S.done(cur); }
        if (!has_next) break;
#pragma unroll
        for (int a = 0; a < 2; ++a)
#pragma unroll
            for (int b = 0; b < 2; ++b)
#pragma unroll
                for (int m = 0; m < 4; ++m)
#pragma unroll
                    for (int n = 0; n < 2; ++n) acc[a][b][m][n] = (f32x4){0.f, 0.f, 0.f, 0.f};
        cur = nxt; cA = nA; cB = nB; ++ui;
        if constexpr (ALIGN_EPI) { if (wr == 1) PG8_BAR; }
    }
    PG8_WAIT_V(0);
    if constexpr (!ALIGN_EPI) { if (wr == 0) PG8_BAR; }
    PG8_BAR;
    if constexpr (Epi::AFTER_DRAIN) { E.fused(acc, cur, wr, wc, fr, fq, lds, wid, lane); S.done(cur); }
#undef PG8_SA
#undef PG8_SB
#undef PG8_STAGE
#undef PG8_LDA
#undef PG8_LDB
#undef PG8_MMA
#undef PG8_WAIT_V
#undef PG8_WAIT_L
#undef PG8_BAR
#undef PG8_SCHED
}
}

struct Args {
    const float* in[35];
    float* out; unsigned char* ws;
    int ph_lo, ph_hi, coop, pad;
};
enum { I_X = 0, I_LNG, I_LNB, I_W1, I_W3, I_W2, I_WIN, I_GATEB, I_PB, I_WOUT, I_MU, I_W0, I_RW2, I_A0, I_A2, I_G2, I_KK, I_KA, I_RK, I_GNG, I_GNB, I_V0, I_V1, I_V2,
       I_GLNG, I_GLNB, I_GWS, I_GSB, I_CW, I_CB, I_WA, I_BA, I_WX, I_BX, I_LAM };

struct Ctx {
    const float* const* in; float* X; unsigned char* ws; unsigned char* lds; int tid, lane, wid, fr, fq, G;
    __device__ __forceinline__ void refresh() { int t = threadIdx.x; asm volatile("" : "+v"(t)); tid = t; lane = t & 63; wid = __builtin_amdgcn_readfirstlane(t >> 6); fr = lane & 15; fq = lane >> 4; }
    __device__ __forceinline__ bf16_t* wsb(size_t off) const { return (bf16_t*)(ws + off); }
    __device__ __forceinline__ bf16_t* small(int l, int off) const { return (bf16_t*)(ws + WS_SMALL) + (size_t)l * SM_L + off; }
};

__device__ __noinline__ void transpose_tiles(const float* src, int ld, int K, int ncols, bf16_t* dst, int ldd, int blk, int blkstride, int off, LAS float* tile, int rot) {
    const int ntn = ncols / 64, ntot = (K / 64) * ntn, tid = threadIdx.x, G = gridDim.x;
    const int wn = tid >> 3, wk = (tid & 7) * 8;
    for (int t = (blockIdx.x + G - (rot % G)) % G; t < ntot; t += 2 * G) {
        const int t2 = t + G; const bool has2 = t2 < ntot;
        const int k0 = (t / ntn) * 64, n0 = (t % ntn) * 64, k02 = has2 ? (t2 / ntn) * 64 : k0, n02 = has2 ? (t2 % ntn) * 64 : n0;
        float ra[8], rb[8];
#pragma unroll
        for (int i = 0; i < 8; ++i) { const int kk = (tid >> 6) + 8 * i, nn = tid & 63; ra[i] = src[(size_t)(k0 + kk) * ld + n0 + nn]; rb[i] = src[(size_t)(k02 + kk) * ld + n02 + nn]; }
#pragma unroll
        for (int i = 0; i < 8; ++i) { const int kk = (tid >> 6) + 8 * i, nn = tid & 63; tile[kk * 65 + nn] = ra[i]; }
        __syncthreads();
        { const int n = n0 + wn; const int row = (n / blk) * blkstride + (n % blk) + off; float v[8];
#pragma unroll
          for (int j = 0; j < 8; ++j) v[j] = tile[(wk + j) * 65 + wn];
          u32x4 w; w.x = cvt_pk_bf16(v[0], v[1]); w.y = cvt_pk_bf16(v[2], v[3]); w.z = cvt_pk_bf16(v[4], v[5]); w.w = cvt_pk_bf16(v[6], v[7]);
          *(u32x4*)(dst + (size_t)row * ldd + k0 + wk) = w; }
        __syncthreads();
        if (has2) {
#pragma unroll
            for (int i = 0; i < 8; ++i) { const int kk = (tid >> 6) + 8 * i, nn = tid & 63; tile[kk * 65 + nn] = rb[i]; }
        }
        __syncthreads();
        if (has2) { const int n = n02 + wn; const int row = (n / blk) * blkstride + (n % blk) + off; float v[8];
#pragma unroll
            for (int j = 0; j < 8; ++j) v[j] = tile[(wk + j) * 65 + wn];
            u32x4 w; w.x = cvt_pk_bf16(v[0], v[1]); w.y = cvt_pk_bf16(v[2], v[3]); w.z = cvt_pk_bf16(v[4], v[5]); w.w = cvt_pk_bf16(v[6], v[7]);
            *(u32x4*)(dst + (size_t)row * ldd + k02 + wk) = w; }
        __syncthreads();
    }
}
__device__ __noinline__ void small_transpose(const float* src, int K, int N, bf16_t* dst) {
    const int tot = K * N;
    for (int i = blockIdx.x * 512 + threadIdx.x; i < tot; i += gridDim.x * 512) { const int n = i / K, k = i % K; dst[i] = f2bf(src[(size_t)k * N + n]); }
}
__device__ void p0_phase(const Ctx& c) {
    LAS float* tile = (LAS float*)c.lds;
    int rot = 0;
    for (int l = 0; l < 2; ++l) {
        for (int f = 0; f < 2; ++f) {
            const int lf = l * 2 + f;
            bf16_t* w13 = c.wsb(WS_W13) + (size_t)lf * 5632 * 1024;
            transpose_tiles(c.in[I_W1] + (size_t)lf * 1024 * FF, FF, 1024, FF, w13, 1024, 128, 256, 0, tile, rot); rot += 704;
            transpose_tiles(c.in[I_W3] + (size_t)lf * 1024 * FF, FF, 1024, FF, w13, 1024, 128, 256, 128, tile, rot); rot += 704;
            transpose_tiles(c.in[I_W2] + (size_t)lf * FF * 1024, 1024, FF, 1024, c.wsb(WS_W2) + (size_t)lf * 1024 * FF, FF, 1 << 20, 0, 0, tile, rot); rot += 704;
        }
        const float* win = c.in[I_WIN] + (size_t)l * 1024 * 6912; bf16_t* wint = c.wsb(WS_WIN) + (size_t)l * 6912 * 1024;
        transpose_tiles(win, 6912, 1024, 1536, wint, 1024, 1 << 20, 0, 0, tile, rot); rot += 384;
        transpose_tiles(win + 1792, 6912, 1024, 2048, wint, 1024, 1 << 20, 0, 1536, tile, rot); rot += 512;
        transpose_tiles(win + 1536, 6912, 1024, 256, wint, 1024, 1 << 20, 0, 3584, tile, rot); rot += 64;
        transpose_tiles(win + 3840, 6912, 1024, 3072, wint, 1024, 1 << 20, 0, 3840, tile, rot); rot += 768;
        for (int i = 0; i < 3; ++i) { transpose_tiles(c.in[I_PB] + (size_t)(l * 3 + i) * 512 * 1024, 1024, 512, 1024, c.wsb(WS_PB) + (size_t)(l * 3 + i) * 1024 * 512, 512, 1 << 20, 0, 0, tile, rot); rot += 128; }
        transpose_tiles(c.in[I_WOUT] + (size_t)l * 1024 * 1024, 1024, 1024, 1024, c.wsb(WS_WO) + (size_t)l * 1024 * 1024, 1024, 1 << 20, 0, 0, tile, rot); rot += 256;
        small_transpose(c.in[I_RW2] + (size_t)l * 64 * 512, 64, 512, c.small(l, SM_W2T));
        small_transpose(c.in[I_A2] + (size_t)l * 64 * 512, 64, 512, c.small(l, SM_A2T));
        small_transpose(c.in[I_G2] + (size_t)l * 128 * 512, 128, 512, c.small(l, SM_G2T));
        for (int h = 0; h < 8; ++h) {
            small_transpose(c.in[I_WA] + (size_t)(l * 8 + h) * 4096, 64, 64, c.small(l, SM_WAT) + h * 4096);
            small_transpose(c.in[I_WX] + (size_t)(l * 8 + h) * 4096, 64, 64, c.small(l, SM_WXT) + h * 4096);
        }
        {
            const float* ws_ = c.in[I_GWS] + (size_t)l * 65536; bf16_t* wm = c.small(l, SM_WM);
            for (int i = blockIdx.x * 512 + threadIdx.x; i < 65536; i += gridDim.x * 512) { const int t = (i >> 7) & 127, s = i & 127; wm[i] = f2bf(s <= t ? ws_[i] : 0.f); }
        }
    }
    {   f32x2* st = (f32x2*)(c.ws + WS_STATS); float* idn = (float*)(c.ws + WS_IDENT);
        for (int i = blockIdx.x * 512 + threadIdx.x; i < T; i += gridDim.x * 512) st[i] = (f32x2){0.f, 1.f};
        for (int i = blockIdx.x * 512 + threadIdx.x; i < 2048; i += gridDim.x * 512) idn[i] = i < 1024 ? 1.f : 0.f; }
    small_transpose(c.in[I_V1], 512, 32, c.small(0, SM_V1T));
    small_transpose(c.in[I_V2], 32, 512, c.small(0, SM_V2T));
    const f32x4* x4 = (const f32x4*)c.in[I_X]; u32x2* xb = (u32x2*)c.wsb(WS_XB);
    {   const size_t stride = (size_t)gridDim.x * 512, n4 = (size_t)T * DM / 4;
        for (size_t i = (size_t)blockIdx.x * 512 + threadIdx.x; i < n4; i += 4 * stride) {
            f32x4 v[4];
#pragma unroll
            for (int u = 0; u < 4; ++u) v[u] = (i + u * stride < n4) ? x4[i + u * stride] : (f32x4){0.f, 0.f, 0.f, 0.f};
#pragma unroll
            for (int u = 0; u < 4; ++u) if (i + u * stride < n4) xb[i + u * stride] = pack4(v[u][0], v[u][1], v[u][2], v[u][3]);
        } }
}

__device__ void ln_phase(const Ctx& c, const float* g, const float* b, bool write_f32) {
    f32x2* stats = (f32x2*)(c.ws + WS_STATS);
    f32x4* X4 = (f32x4*)c.X; u32x2* xb = (u32x2*)c.wsb(WS_XB);
    const f32x4* g4 = (const f32x4*)g; const f32x4* b4 = (const f32x4*)b;
    f32x4 gv[4], bv[4];
#pragma unroll
    for (int j = 0; j < 4; ++j) { gv[j] = g4[c.lane + 64 * j]; bv[j] = b4[c.lane + 64 * j]; }
    constexpr int NR = 4;
    for (int row = (blockIdx.x * 8 + c.wid) * NR; row < T; row += c.G * 8 * NR) {
        f32x4 v[NR][4];
#pragma unroll
        for (int r = 0; r < NR; ++r)
#pragma unroll
            for (int j = 0; j < 4; ++j) v[r][j] = X4[(size_t)(row + r) * 256 + c.lane + 64 * j];
#pragma unroll
        for (int r = 0; r < NR; ++r) {
            float s = 0.f;
#pragma unroll
            for (int j = 0; j < 4; ++j) s += (v[r][j][0] + v[r][j][1]) + (v[r][j][2] + v[r][j][3]);
            const float mean = wave_sum(s) * (1.0f / 1024.0f); float q = 0.f;
#pragma unroll
            for (int j = 0; j < 4; ++j) { const f32x4 d = v[r][j] - mean; q += (d[0] * d[0] + d[1] * d[1]) + (d[2] * d[2] + d[3] * d[3]); }
            const float rstd = rsqrtf(wave_sum(q) * (1.0f / 1024.0f) + LN_EPS);
            if (c.lane == 0) stats[row + r] = (f32x2){mean, rstd};
#pragma unroll
            for (int j = 0; j < 4; ++j) { const f32x4 y = (v[r][j] - mean) * rstd * gv[j] + bv[j];
                if (write_f32) X4[(size_t)(row + r) * 256 + c.lane + 64 * j] = y; xb[(size_t)(row + r) * 256 + c.lane + 64 * j] = pack4(y[0], y[1], y[2], y[3]); }
        }
    }
}

template <int L1> __device__ void prep_phase(const Ctx& c, int l) {
    LAS bf16_t* XW = (LAS bf16_t*)c.lds;
    LAS bf16_t* XA = XW + 64 * 72;
    LAS bf16_t* VS = XA + 64 * 72;
    LAS bf16_t* VD = VS + 64 * 520;
    bf16_t* Rb = c.wsb(WS_B0); bf16_t* Kb = c.wsb(WS_B1); bf16_t* Vb = c.wsb(WS_B2); bf16_t* MISC = c.wsb(WS_B7);
    bf16_t* LD = c.wsb(WS_LD); bf16_t* KKo = c.wsb(WS_KK); bf16_t* BBo = c.wsb(WS_BB); bf16_t* VF = c.wsb(WS_VF);
    const bf16_t* halo = c.wsb(WS_HALO);
    const float* mu = c.in[I_MU] + l * 1792;
    const bf16_t* w2T = c.small(l, SM_W2T); const bf16_t* a2T = c.small(l, SM_A2T); const bf16_t* v1T = c.small(0, SM_V1T); const bf16_t* v2T = c.small(0, SM_V2T);
    const float* w0 = c.in[I_W0] + l * 512; const float* a0 = c.in[I_A0] + l * 512; const float* k_k = c.in[I_KK] + l * 512; const float* k_a = c.in[I_KA] + l * 512;
    const float* v0 = c.in[I_V0];
    const int tid = c.tid, w = c.wid, fr = c.fr, fq = c.fq;
    for (int tile = blockIdx.x; tile < T / 64; tile += c.G) {
        const int t0 = tile * 64; const bool seqstart = (t0 % SEQ) == 0;
        u32x4 keep[4];
        {
            const int ch = tid & 31, cc = ch * 8;
            float m8[8];
#pragma unroll
            for (int j = 0; j < 8; ++j) m8[j] = mu[1536 + cc + j];
#pragma unroll
            for (int i = 0; i < 4; ++i) {
                const int row = (tid >> 5) + 16 * i, t = t0 + row;
                float cur[8], prv[8];
                unpack8(*(const u32x4*)(MISC + (size_t)t * 256 + cc), cur);
                if (row > 0) unpack8(*(const u32x4*)(MISC + (size_t)(t - 1) * 256 + cc), prv);
                else if (seqstart) {
#pragma unroll
                    for (int j = 0; j < 8; ++j) prv[j] = 0.f;
                } else unpack8(*(const u32x4*)(halo + (size_t)(tile - 1) * 1792 + 1536 + cc), prv);
                float s[8];
#pragma unroll
                for (int j = 0; j < 8; ++j) s[j] = cur[j] + m8[j] * (prv[j] - cur[j]);
                if (ch < 8) {
#pragma unroll
                    for (int j = 0; j < 8; ++j) XW[row * 72 + cc + j] = f2bf(tanhf_(s[j]));
                } else if (ch < 16) {
#pragma unroll
                    for (int j = 0; j < 8; ++j) XA[row * 72 + cc - 64 + j] = f2bf(s[j]);
                } else {
                    keep[i].x = cvt_pk_bf16(sigmoidf_(s[0]), sigmoidf_(s[1])); keep[i].y = cvt_pk_bf16(sigmoidf_(s[2]), sigmoidf_(s[3]));
                    keep[i].z = cvt_pk_bf16(sigmoidf_(s[4]), sigmoidf_(s[5])); keep[i].w = cvt_pk_bf16(sigmoidf_(s[6]), sigmoidf_(s[7]));
                }
            }
        }
        if (L1) {
#pragma unroll 1
            for (int mt = 0; mt < 4; ++mt)
#pragma unroll
                for (int nt = 0; nt < 4; ++nt) {
                    const int rt = 16 * mt + fr, t = t0 + rt, cc = 64 * w + 16 * nt + 4 * fq;
                    float cur[4], prv[4];
                    unpack4(*(const u32x2*)(Vb + (size_t)t * 512 + cc), cur);
                    if (rt > 0) unpack4(*(const u32x2*)(Vb + (size_t)(t - 1) * 512 + cc), prv);
                    else if (seqstart) { prv[0] = prv[1] = prv[2] = prv[3] = 0.f; }
                    else unpack4(*(const u32x2*)(halo + (size_t)(tile - 1) * 1792 + 1024 + cc), prv);
                    float s[4];
#pragma unroll
                    for (int j = 0; j < 4; ++j) s[j] = cur[j] + mu[1024 + cc + j] * (prv[j] - cur[j]);
                    *(LAS u32x2*)(VS + rt * 520 + cc) = pack4(s[0], s[1], s[2], s[3]);
                }
        }
        __syncthreads();
        if ((tid & 31) >= 16) {
#pragma unroll
            for (int i = 0; i < 4; ++i) { const int row = (tid >> 5) + 16 * i; *(u32x4*)(MISC + (size_t)(t0 + row) * 256 + (tid & 31) * 8) = keep[i]; }
        }
        if (L1) {
            const int mt = w >> 1, ntl = w & 1;
            f32x4 acc = (f32x4){0.f, 0.f, 0.f, 0.f};
#pragma unroll 4
            for (int ks = 0; ks < 16; ++ks) {
                const bf16x8 first = *(const bf16x8*)(v1T + (size_t)(16 * ntl + fr) * 512 + 32 * ks + 8 * fq);
                const bf16x8 second = *(const LAS bf16x8*)(VS + (16 * mt + fr) * 520 + 32 * ks + 8 * fq);
                acc = MFMA16(first, second, acc);
            }
            *(LAS u32x2*)(VD + (16 * mt + fr) * 40 + 16 * ntl + 4 * fq) = pack4(acc[0], acc[1], acc[2], acc[3]);
            __syncthreads();
        }
#pragma unroll 1
        for (int mt = 3; mt >= 0; --mt) {
            int wz = 64 * w; asm volatile("" : "+v"(wz));
            const int rt = 16 * mt + fr, t = t0 + rt;
            f32x4 aw[4], aa[4], av[4];
#pragma unroll
            for (int nt = 0; nt < 4; ++nt) {
                aw[nt] = (f32x4){0.f, 0.f, 0.f, 0.f}; aa[nt] = (f32x4){0.f, 0.f, 0.f, 0.f}; av[nt] = (f32x4){0.f, 0.f, 0.f, 0.f};
#pragma unroll
                for (int ks = 0; ks < 2; ++ks) {
                    const bf16x8 xw = *(const LAS bf16x8*)(XW + rt * 72 + 32 * ks + 8 * fq);
                    const bf16x8 xa = *(const LAS bf16x8*)(XA + rt * 72 + 32 * ks + 8 * fq);
                    const bf16x8 fw = *(const bf16x8*)(w2T + (size_t)(wz + 16 * nt + fr) * 64 + 32 * ks + 8 * fq);
                    const bf16x8 fa = *(const bf16x8*)(a2T + (size_t)(wz + 16 * nt + fr) * 64 + 32 * ks + 8 * fq);
                    aw[nt] = MFMA16(fw, xw, aw[nt]); aa[nt] = MFMA16(fa, xa, aa[nt]);
                }
                if (L1) {
                    const bf16x8 fv = *(const bf16x8*)(v2T + (size_t)(wz + 16 * nt + fr) * 32 + 8 * fq);
                    const bf16x8 xv = *(const LAS bf16x8*)(VD + rt * 40 + 8 * fq);
                    av[nt] = MFMA16(fv, xv, av[nt]);
                }
            }
            float kkv[4][4], av_[4][4]; float sumsq = 0.f;
#pragma unroll
            for (int nt = 0; nt < 4; ++nt) {
                const int cc = wz + 16 * nt + 4 * fq;
                float cr[4], ck[4], cv[4], pr[4], pk[4], pv[4];
                unpack4(*(const u32x2*)(Rb + (size_t)t * 512 + cc), cr); unpack4(*(const u32x2*)(Kb + (size_t)t * 512 + cc), ck); unpack4(*(const u32x2*)(Vb + (size_t)t * 512 + cc), cv);
                if (rt > 0) { unpack4(*(const u32x2*)(Rb + (size_t)(t - 1) * 512 + cc), pr); unpack4(*(const u32x2*)(Kb + (size_t)(t - 1) * 512 + cc), pk); unpack4(*(const u32x2*)(Vb + (size_t)(t - 1) * 512 + cc), pv); }
                else if (seqstart) {
#pragma unroll
                    for (int j = 0; j < 4; ++j) { pr[j] = 0.f; pk[j] = 0.f; pv[j] = 0.f; }
                } else { const bf16_t* hp = halo + (size_t)(tile - 1) * 1792 + cc; unpack4(*(const u32x2*)(hp), pr); unpack4(*(const u32x2*)(hp + 512), pk); unpack4(*(const u32x2*)(hp + 1024), pv); }
                const f32x4 mur = *(const f32x4*)(mu + cc), muk = *(const f32x4*)(mu + 512 + cc), muv = *(const f32x4*)(mu + 1024 + cc);
                const f32x4 w0v = *(const f32x4*)(w0 + cc), a0v = *(const f32x4*)(a0 + cc), kkp = *(const f32x4*)(k_k + cc), kap = *(const f32x4*)(k_a + cc);
                float rs[4], ldv[4], kp[4], vp[4], vsn[4];
#pragma unroll
                for (int j = 0; j < 4; ++j) {
                    rs[j] = cr[j] + mur[j] * (pr[j] - cr[j]);
                    const float ksj = ck[j] + muk[j] * (pk[j] - ck[j]);
                    vsn[j] = cv[j] + muv[j] * (pv[j] - cv[j]);
                    const float wl = w0v[j] + aw[nt][j];
                    const float wlog = -softplusf_(-wl) - 0.5f;
                    ldv[j] = -__expf(wlog);
                    const float a = sigmoidf_(a0v[j] + aa[nt][j]);
                    av_[nt][j] = a;
                    const float kv = ksj * kkp[j];
                    kkv[nt][j] = kv; sumsq += kv * kv;
                    kp[j] = ksj * (1.0f + (a - 1.0f) * kap[j]);
                    vp[j] = vsn[j];
                }
                if (L1) {
                    float vf[4]; unpack4(*(const u32x2*)(VF + (size_t)t * 512 + cc), vf);
                    const f32x4 v0v = *(const f32x4*)(v0 + cc);
#pragma unroll
                    for (int j = 0; j < 4; ++j) vp[j] = vsn[j] + (vf[j] - vsn[j]) * sigmoidf_(v0v[j] + av[nt][j]);
                } else {
                    *(u32x2*)(VF + (size_t)t * 512 + cc) = pack4(vsn[0], vsn[1], vsn[2], vsn[3]);
                }
                *(u32x2*)(Rb + (size_t)t * 512 + cc) = pack4(rs[0], rs[1], rs[2], rs[3]);
                *(u32x2*)(Kb + (size_t)t * 512 + cc) = pack4(kp[0], kp[1], kp[2], kp[3]);
                *(u32x2*)(Vb + (size_t)t * 512 + cc) = pack4(vp[0], vp[1], vp[2], vp[3]);
                *(u32x2*)(LD + (size_t)t * 512 + cc) = pack4(ldv[0], ldv[1], ldv[2], ldv[3]);
            }
            sumsq += __shfl_xor(sumsq, 16); sumsq += __shfl_xor(sumsq, 32);
            const float inv = rsqrtf(fmaxf(sumsq, 1e-24f));
#pragma unroll
            for (int nt = 0; nt < 4; ++nt) {
                const int cc = wz + 16 * nt + 4 * fq;
                float kn[4], bb[4];
#pragma unroll
                for (int j = 0; j < 4; ++j) { kn[j] = kkv[nt][j] * inv; bb[j] = kn[j] * av_[nt][j]; }
                *(u32x2*)(KKo + (size_t)t * 512 + cc) = pack4(kn[0], kn[1], kn[2], kn[3]);
                *(u32x2*)(BBo + (size_t)t * 512 + cc) = pack4(bb[0], bb[1], bb[2], bb[3]);
            }
        }
        __syncthreads();
    }
}

__device__ void scan_phase(const Ctx& c) {
    constexpr int RW = 16;
    const int bh = blockIdx.x & 63, rq = blockIdx.x >> 6, b = bh >> 3, h = bh & 7;
    if (rq >= 64 / RW) return;
    const size_t tb = (size_t)b * SEQ; const int col0 = h * 64, rbase = rq * RW;
    LAS float* L = (LAS float*)c.lds;
    constexpr int BUFW = 6 * 2048 + 64;
    LAS float* OUT = L + 2 * BUFW;
    const bf16_t* Rb = c.wsb(WS_B0); const bf16_t* Kb = c.wsb(WS_B1); const bf16_t* Vb = c.wsb(WS_B2);
    const bf16_t* LD = c.wsb(WS_LD); const bf16_t* KKi = c.wsb(WS_KK); const bf16_t* BBo = c.wsb(WS_BB); bf16_t* OS = c.wsb(WS_B5);
    const int tid = c.tid, ss = tid >> 4, kq = (tid & 15) * 4, row = rbase + (tid >> 4), kg = tid & 15;
    const bool comp = tid < RW * 16;
    f32x4 S0 = (f32x4){0.f, 0.f, 0.f, 0.f};
    u32x2 gr, gk, gv, gl, gkk, gb;
#define SCAN_LOAD(chunk) do { const size_t o_ = (tb + (size_t)(chunk) * 32 + ss) * 512 + col0 + kq; \
        gr = *(const u32x2*)(Rb + o_); gk = *(const u32x2*)(Kb + o_); gv = *(const u32x2*)(Vb + o_); gl = *(const u32x2*)(LD + o_); gkk = *(const u32x2*)(KKi + o_); gb = *(const u32x2*)(BBo + o_); } while (0)
#define SCAN_STAGE(bufi) do { LAS float* B_ = L + (bufi) * BUFW; float r_[4], k_[4], v_[4], l_[4], n_[4], b_[4]; \
        unpack4(gr, r_); unpack4(gk, k_); unpack4(gv, v_); unpack4(gl, l_); unpack4(gkk, n_); unpack4(gb, b_); \
        float w_[4]; _Pragma("unroll") for (int j = 0; j < 4; ++j) w_[j] = __expf(l_[j]); \
        const int o_ = ss * 64 + kq; \
        *(LAS f32x4*)(B_ + 2 * o_) = (f32x4){-n_[0], w_[0] * r_[0], -n_[1], w_[1] * r_[1]}; \
        *(LAS f32x4*)(B_ + 2 * o_ + 4) = (f32x4){-n_[2], w_[2] * r_[2], -n_[3], w_[3] * r_[3]}; \
        *(LAS f32x4*)(B_ + 4096 + o_) = (f32x4){w_[0], w_[1], w_[2], w_[3]}; \
        *(LAS f32x4*)(B_ + 6144 + o_) = (f32x4){b_[0], b_[1], b_[2], b_[3]}; \
        *(LAS f32x4*)(B_ + 8192 + o_) = (f32x4){k_[0], k_[1], k_[2], k_[3]}; \
        *(LAS f32x4*)(B_ + 10240 + o_) = (f32x4){v_[0], v_[1], v_[2], v_[3]}; \
        float br_ = (b_[0] * r_[0] + b_[1] * r_[1]) + (b_[2] * r_[2] + b_[3] * r_[3]); float kr_ = (k_[0] * r_[0] + k_[1] * r_[1]) + (k_[2] * r_[2] + k_[3] * r_[3]); \
        br_ += dppf<0xB1>(br_); kr_ += dppf<0xB1>(kr_); br_ += dppf<0x4E>(br_); kr_ += dppf<0x4E>(kr_); \
        br_ += dppf<0x141>(br_); kr_ += dppf<0x141>(kr_); br_ += dppf<0x140>(br_); kr_ += dppf<0x140>(kr_); \
        if ((tid & 15) == 0) { B_[12288 + 2 * ss] = br_; B_[12288 + 2 * ss + 1] = kr_; } } while (0)
    SCAN_LOAD(0); SCAN_STAGE(0);
    __syncthreads();
#pragma unroll 1
    for (int ch = 0; ch < SEQ / 32; ++ch) {
        if (ch + 1 < SEQ / 32) SCAN_LOAD(ch + 1);
        LAS float* B = L + (ch & 1) * BUFW;
        if (comp) {
            f32x4 A0[2], R0[2], W0[2], B0[2], K0[2]; float Vv[2], Br[2], Kr[2];
#define SCAN_FETCH(q, s_) do { const int o_ = (s_) * 64 + kg * 4; \
            A0[q] = *(LAS f32x4*)(B + 2 * o_); R0[q] = *(LAS f32x4*)(B + 2 * o_ + 4); W0[q] = *(LAS f32x4*)(B + 4096 + o_);     B0[q] = *(LAS f32x4*)(B + 6144 + o_); K0[q] = *(LAS f32x4*)(B + 8192 + o_); \
            Vv[q] = B[10240 + (s_) * 64 + row]; Br[q] = B[12288 + 2 * (s_)]; Kr[q] = B[12288 + 2 * (s_) + 1]; } while (0)
#define SCAN_STEP(q, s_) do { \
            f32x2 pp = (f32x2){A0[q][0], A0[q][1]} * S0[0]; pp += (f32x2){A0[q][2], A0[q][3]} * S0[1]; pp += (f32x2){R0[q][0], R0[q][1]} * S0[2]; pp += (f32x2){R0[q][2], R0[q][3]} * S0[3]; \
            float p0 = pp[0], p1 = pp[1]; \
            p0 += dppf<0xB1>(p0); p1 += dppf<0xB1>(p1); p0 += dppf<0x4E>(p0); p1 += dppf<0x4E>(p1); p0 += dppf<0x141>(p0); p1 += dppf<0x141>(p1); p0 += dppf<0x140>(p0); p1 += dppf<0x140>(p1); \
            const float v_ = Vv[q]; \
            S0 = S0 * W0[q] + (B0[q] * p0 + K0[q] * v_); \
            const float o_ = p1 + p0 * Br[q] + v_ * Kr[q]; \
            OUT[(s_) * (RW * 16) + tid] = o_; } while (0)
            SCAN_FETCH(0, 0);
#pragma unroll
            for (int s = 0; s < 32; s += 2) {
                SCAN_FETCH(1, s + 1);
                SCAN_STEP(0, s);
                if (s + 2 < 32) SCAN_FETCH(0, s + 2);
                SCAN_STEP(1, s + 1);
            }
#undef SCAN_FETCH
#undef SCAN_STEP
        }
        __syncthreads();
        { const int st = tid >> 4, r = tid & 15; OS[(tb + (size_t)ch * 32 + st) * 512 + col0 + rbase + r] = f2bf(OUT[st * (RW * 16) + r * 16]); }
        if (ch + 1 < SEQ / 32) SCAN_STAGE((ch + 1) & 1);
        __syncthreads();
    }
#undef SCAN_LOAD
#undef SCAN_STAGE
}

__device__ void gmlp_lru_phase(const Ctx& c, int l, int first_wg) {
    LAS float* ST = (LAS float*)c.lds;
    LAS bf16_t* VT = (LAS bf16_t*)(c.lds + 1024);
    LAS bf16_t* WL = (LAS bf16_t*)(c.lds + 36864);
    bf16_t* GU = c.wsb(WS_B3); bf16_t* GV = c.wsb(WS_B4); const bf16_t* LX = c.wsb(WS_B5); bf16_t* LY = c.wsb(WS_B6);
    float* Pend = (float*)(c.ws + WS_LRUS); float* Hend = Pend + 512 * 512;
    const float* lng = c.in[I_GLNG] + l * 512; const float* lnb = c.in[I_GLNB] + l * 512; const float* sb = c.in[I_GSB] + l * 512;
    const bf16_t* Wm = c.small(l, SM_WM); const bf16_t* waT = c.small(l, SM_WAT); const bf16_t* wxT = c.small(l, SM_WXT);
    const float* cw = c.in[I_CW] + l * 4 * 512; const float* cb = c.in[I_CB] + l * 512; const float* ba = c.in[I_BA] + l * 512; const float* bx = c.in[I_BX] + l * 512; const float* lam = c.in[I_LAM] + l * 512;
    const int tid = c.tid, w = c.wid, fr = c.fr, fq = c.fq, lane = c.lane;
    const int nwg = c.G - first_wg;
    for (int tile = blockIdx.x - first_wg; tile < T / 128; tile += nwg) {
        const int t0 = tile * 128; const int pos0 = t0 % SEQ;
#pragma unroll 4
        for (int i = 0; i < 16; ++i) {
            const int rt = 16 * w + i; float x[8]; unpack8(*(const u32x4*)(GV + (size_t)(t0 + rt) * 512 + lane * 8), x);
            float s = 0.f;
#pragma unroll
            for (int j = 0; j < 8; ++j) { x[j] = geluf_(x[j]); s += x[j]; }
            const float mean = wave_sum(s) * (1.0f / 512.0f); float q = 0.f;
#pragma unroll
            for (int j = 0; j < 8; ++j) { const float d = x[j] - mean; q += d * d; }
            const float rstd = rsqrtf(wave_sum(q) * (1.0f / 512.0f) + LN_EPS);
            if (lane == 0) { ST[2 * rt] = mean; ST[2 * rt + 1] = rstd; }
        }
        __syncthreads();
#pragma unroll 1
        for (int g = 0; g < 4; ++g) {
#pragma unroll
            for (int i = 0; i < 4; ++i) {
                const int idx = tid + 512 * i, s = idx >> 4, dc = (idx & 15) * 8;
                float x[8]; unpack8(*(const u32x4*)(GV + (size_t)(t0 + s) * 512 + g * 128 + dc), x);
                const float mean = ST[2 * s], rstd = ST[2 * s + 1];
#pragma unroll
                for (int j = 0; j < 8; ++j) VT[(dc + j) * 136 + s] = f2bf((geluf_(x[j]) - mean) * rstd * lng[g * 128 + dc + j] + lnb[g * 128 + dc + j]);
            }
#pragma unroll
            for (int i = 0; i < 4; ++i) { const int idx = tid + 512 * i, tr = idx >> 4, sc = (idx & 15) * 8;
                *(LAS u32x4*)(WL + tr * 136 + sc) = *(const u32x4*)(Wm + (size_t)g * 16384 + tr * 128 + sc); }
            __syncthreads();
#pragma unroll 1
            for (int tbk = 0; tbk < 8; ++tbk) {
                f32x4 acc = (f32x4){0.f, 0.f, 0.f, 0.f};
                const int nks = (tbk >> 1) + 1;
                for (int ks = 0; ks < nks; ++ks) {
                    const bf16x8 first = *(const LAS bf16x8*)(VT + (16 * w + fr) * 136 + 32 * ks + 8 * fq);
                    const bf16x8 second = *(const LAS bf16x8*)(WL + (16 * tbk + fr) * 136 + 32 * ks + 8 * fq);
                    acc = MFMA16(first, second, acc);
                }
                const int rt = 16 * tbk + fr, cc = g * 128 + 16 * w + 4 * fq;
                float u[4]; unpack4(*(const u32x2*)(GU + (size_t)(t0 + rt) * 512 + cc), u);
                const float sbv = sb[g * 128 + rt];
                *(u32x2*)(GU + (size_t)(t0 + rt) * 512 + cc) = pack4(geluf_(u[0]) * (acc[0] + sbv), geluf_(u[1]) * (acc[1] + sbv), geluf_(u[2]) * (acc[2] + sbv), geluf_(u[3]) * (acc[3] + sbv));
            }
            __syncthreads();
        }
        {
            float hc[4][4], pc[4][4], spl[4][4];
#pragma unroll
            for (int nt = 0; nt < 4; ++nt)
#pragma unroll
                for (int j = 0; j < 4; ++j) { hc[nt][j] = 0.f; pc[nt][j] = 1.f; spl[nt][j] = 8.0f * softplus_precise(-lam[64 * w + 16 * nt + 4 * fq + j]); }
#pragma unroll 1
            for (int mt = 0; mt < 8; ++mt) {
                int wz = 64 * w; asm volatile("" : "+v"(wz));
                const int rt = 16 * mt + fr, t = t0 + rt, pos = pos0 + rt;
                bf16x8 xop[2];
#pragma unroll
                for (int ks = 0; ks < 2; ++ks) {
                    const int cc = wz + 32 * ks + 8 * fq; float a8[8];
#pragma unroll
                    for (int j = 0; j < 8; ++j) a8[j] = cb[cc + j];
#pragma unroll
                    for (int jj = 0; jj < 4; ++jj) {
                        if (pos - 3 + jj >= 0) { float x[8]; unpack8(*(const u32x4*)(LX + (size_t)(t - 3 + jj) * 512 + cc), x);
#pragma unroll
                            for (int j = 0; j < 8; ++j) a8[j] += x[j] * cw[jj * 512 + cc + j]; }
                    }
                    u32x4 pk; pk.x = cvt_pk_bf16(a8[0], a8[1]); pk.y = cvt_pk_bf16(a8[2], a8[3]); pk.z = cvt_pk_bf16(a8[4], a8[5]); pk.w = cvt_pk_bf16(a8[6], a8[7]);
                    xop[ks] = __builtin_bit_cast(bf16x8, pk);
                }
#pragma unroll
                for (int nt = 0; nt < 4; ++nt) {
                    f32x4 accA = (f32x4){0.f, 0.f, 0.f, 0.f}, accX = (f32x4){0.f, 0.f, 0.f, 0.f};
#pragma unroll
                    for (int ks = 0; ks < 2; ++ks) {
                        const bf16x8 fa = *(const bf16x8*)(waT + (size_t)(wz + 16 * nt + fr) * 64 + 32 * ks + 8 * fq);
                        const bf16x8 fx = *(const bf16x8*)(wxT + (size_t)(wz + 16 * nt + fr) * 64 + 32 * ks + 8 * fq);
                        accA = MFMA16(fa, xop[ks], accA); accX = MFMA16(fx, xop[ks], accX);
                    }
                    const int cc = wz + 16 * nt + 4 * fq;
                    float xc[4];
#pragma unroll
                    for (int j = 0; j < 4; ++j) xc[j] = cb[cc + j];
#pragma unroll
                    for (int jj = 0; jj < 4; ++jj) {
                        if (pos - 3 + jj >= 0) { float x[4]; unpack4(*(const u32x2*)(LX + (size_t)(t - 3 + jj) * 512 + cc), x);
#pragma unroll
                            for (int j = 0; j < 4; ++j) xc[j] += x[j] * cw[jj * 512 + cc + j]; }
                    }
                    float yv[4]; unpack4(*(const u32x2*)(LY + (size_t)t * 512 + cc), yv);
                    float A[4], Bv[4];
#pragma unroll
                    for (int j = 0; j < 4; ++j) {
                        const float rg = sigmoidf_(accA[j] + ba[cc + j]), ig = sigmoidf_(accX[j] + bx[cc + j]);
                        const float log_a = -rg * spl[nt][j];
                        A[j] = __expf(log_a);
                        Bv[j] = sqrtf(fmaxf((1.0f - A[j]) * (1.0f + A[j]), 0.f)) * (ig * xc[j]);
                    }
#pragma unroll
                    for (int j = 0; j < 4; ++j) {
                        float a = A[j], bq = Bv[j];
                        { const float ap = dppf_old<0x111>(1.f, a), bp = dppf_old<0x111>(0.f, bq); bq = a * bp + bq; a = a * ap; }
                        { const float ap = dppf_old<0x112>(1.f, a), bp = dppf_old<0x112>(0.f, bq); bq = a * bp + bq; a = a * ap; }
                        { const float ap = dppf_old<0x114>(1.f, a), bp = dppf_old<0x114>(0.f, bq); bq = a * bp + bq; a = a * ap; }
                        { const float ap = dppf_old<0x118>(1.f, a), bp = dppf_old<0x118>(0.f, bq); bq = a * bp + bq; a = a * ap; }
                        const float hh = bq + a * hc[nt][j], pp = a * pc[nt][j];
                        A[j] = pp; Bv[j] = hh;
                        hc[nt][j] = __shfl(hh, (lane & 48) | 15); pc[nt][j] = __shfl(pp, (lane & 48) | 15);
                    }
                    const float y0 = geluf_(yv[0]), y1 = geluf_(yv[1]), y2 = geluf_(yv[2]), y3 = geluf_(yv[3]);
                    *(u32x2*)(GV + (size_t)t * 512 + cc) = pack4(y0 * Bv[0], y1 * Bv[1], y2 * Bv[2], y3 * Bv[3]);
                    *(u32x2*)(LY + (size_t)t * 512 + cc) = pack4(y0 * A[0], y1 * A[1], y2 * A[2], y3 * A[3]);
                }
            }
            if (fr == 0) {
#pragma unroll
                for (int nt = 0; nt < 4; ++nt) { const int cc = 64 * w + 16 * nt + 4 * fq;
                    *(f32x4*)(Pend + (size_t)tile * 512 + cc) = (f32x4){pc[nt][0], pc[nt][1], pc[nt][2], pc[nt][3]};
                    *(f32x4*)(Hend + (size_t)tile * 512 + cc) = (f32x4){hc[nt][0], hc[nt][1], hc[nt][2], hc[nt][3]}; }
            }
        }
        __syncthreads();
    }
}

__device__ void post_phase(const Ctx& c, int l) {
    const int tid = c.tid, w = c.wid, fr = c.fr, fq = c.fq;
    {
        LAS float* CARRY = (LAS float*)c.lds;
        const float* Pend = (const float*)(c.ws + WS_LRUS); const float* Hend = Pend + 512 * 512;
        bf16_t* YH = c.wsb(WS_B4); const bf16_t* YP = c.wsb(WS_B6);
        for (int tile = blockIdx.x; tile < T / 128; tile += c.G) {
            const int ci = tile & 63, base = tile - ci; float carry = 0.f;
            {
                int j = 0;
                for (; j + 8 <= ci; j += 8) {
                    float hv[8], pv[8];
#pragma unroll
                    for (int u = 0; u < 8; ++u) { hv[u] = Hend[(size_t)(base + j + u) * 512 + tid]; pv[u] = Pend[(size_t)(base + j + u) * 512 + tid]; }
#pragma unroll
                    for (int u = 0; u < 8; ++u) carry = hv[u] + pv[u] * carry;
                }
                for (; j < ci; ++j) carry = Hend[(size_t)(base + j) * 512 + tid] + Pend[(size_t)(base + j) * 512 + tid] * carry;
            }
            CARRY[tid] = carry;
            __syncthreads();
            if (ci > 0) {
#pragma unroll 4
                for (int i = 0; i < 16; ++i) {
                    const int idx = tid + 512 * i, row = idx >> 6, cc = (idx & 63) * 8; const size_t o = (size_t)(tile * 128 + row) * 512 + cc;
                    float a[8], p[8]; unpack8(*(const u32x4*)(YH + o), a); unpack8(*(const u32x4*)(YP + o), p);
#pragma unroll
                    for (int j = 0; j < 8; ++j) a[j] += p[j] * CARRY[cc + j];
                    u32x4 pk; pk.x = cvt_pk_bf16(a[0], a[1]); pk.y = cvt_pk_bf16(a[2], a[3]); pk.z = cvt_pk_bf16(a[4], a[5]); pk.w = cvt_pk_bf16(a[6], a[7]);
                    *(u32x4*)(YH + o) = pk;
                }
            }
            __syncthreads();
        }
    }
    LAS bf16_t* SG = (LAS bf16_t*)c.lds;
    bf16_t* Rb = c.wsb(WS_B0); const bf16_t* Kb = c.wsb(WS_B1); const bf16_t* Vb = c.wsb(WS_B2); const bf16_t* MISC = c.wsb(WS_B7); const bf16_t* OS = c.wsb(WS_B5);
    const bf16_t* g2T = c.small(l, SM_G2T);
    const float* r_k = c.in[I_RK] + l * 512; const float* gng = c.in[I_GNG] + l * 512; const float* gnb = c.in[I_GNB] + l * 512;
    for (int tile = blockIdx.x; tile < T / 64; tile += c.G) {
        const int t0 = tile * 64;
#pragma unroll
        for (int i = 0; i < 2; ++i) { const int idx = tid + 512 * i, row = idx >> 4, cc = (idx & 15) * 8;
            *(LAS u32x4*)(SG + row * 136 + cc) = *(const u32x4*)(MISC + (size_t)(t0 + row) * 256 + 128 + cc); }
        __syncthreads();
#pragma unroll 1
        for (int mt = 0; mt < 4; ++mt) {
            int wz = 64 * w; asm volatile("" : "+v"(wz));
            const int rt = 16 * mt + fr, t = t0 + rt;
            f32x4 ag[4];
#pragma unroll
            for (int nt = 0; nt < 4; ++nt) {
                ag[nt] = (f32x4){0.f, 0.f, 0.f, 0.f};
#pragma unroll
                for (int ks = 0; ks < 4; ++ks) {
                    const bf16x8 first = *(const bf16x8*)(g2T + (size_t)(wz + 16 * nt + fr) * 128 + 32 * ks + 8 * fq);
                    const bf16x8 second = *(const LAS bf16x8*)(SG + rt * 136 + 32 * ks + 8 * fq);
                    ag[nt] = MFMA16(first, second, ag[nt]);
                }
            }
            float o[4][4], vv[4][4]; float so = 0.f, sbn = 0.f;
#pragma unroll
            for (int nt = 0; nt < 4; ++nt) {
                const int cc = wz + 16 * nt + 4 * fq; const size_t off = (size_t)t * 512 + cc;
                float r[4], k[4];
                unpack4(*(const u32x2*)(OS + off), o[nt]); unpack4(*(const u32x2*)(Rb + off), r); unpack4(*(const u32x2*)(Kb + off), k); unpack4(*(const u32x2*)(Vb + off), vv[nt]);
#pragma unroll
                for (int j = 0; j < 4; ++j) { so += o[nt][j]; sbn += r[j] * k[j] * r_k[cc + j]; }
            }
            so += __shfl_xor(so, 16); so += __shfl_xor(so, 32); sbn += __shfl_xor(sbn, 16); sbn += __shfl_xor(sbn, 32);
            const float mean = so * (1.0f / 64.0f); float q = 0.f;
#pragma unroll
            for (int nt = 0; nt < 4; ++nt)
#pragma unroll
                for (int j = 0; j < 4; ++j) { const float d = o[nt][j] - mean; q += d * d; }
            q += __shfl_xor(q, 16); q += __shfl_xor(q, 32);
            const float rstd = rsqrtf(q * (1.0f / 64.0f) + GN_EPS);
#pragma unroll
            for (int nt = 0; nt < 4; ++nt) {
                const int cc = wz + 16 * nt + 4 * fq; float y[4];
#pragma unroll
                for (int j = 0; j < 4; ++j) y[j] = ((o[nt][j] - mean) * rstd * gng[cc + j] + gnb[cc + j] + sbn * vv[nt][j]) * ag[nt][j];
                *(u32x2*)(Rb + (size_t)t * 512 + cc) = pack4(y[0], y[1], y[2], y[3]);
            }
        }
        __syncthreads();
    }
}

__device__ void merge_phase(const Ctx& c, const float* bias, int first) {
    const u32x4* G = (const u32x4*)c.wsb(WS_B1); const u32x4* P = (const u32x4*)c.wsb(WS_B5); u32x4* M = (u32x4*)c.wsb(WS_LD);
    const size_t n = (size_t)T * DM / 8;
    for (size_t i = (size_t)blockIdx.x * 512 + c.tid; i < n; i += (size_t)c.G * 512) {
        const int col = (int)(i & 127) * 8;
        float g[8], p[8], m[8];
        unpack8(G[i], g); unpack8(P[i], p);
        if (first) {
#pragma unroll
            for (int j = 0; j < 8; ++j) m[j] = 0.f;
        } else unpack8(M[i], m);
        const f32x4 b0 = *(const f32x4*)(bias + col), b1 = *(const f32x4*)(bias + col + 4);
#pragma unroll
        for (int j = 0; j < 4; ++j) { m[j] += sigmoidf_(g[j] + b0[j]) * p[j]; m[4 + j] += sigmoidf_(g[4 + j] + b1[j]) * p[4 + j]; }
        u32x4 w; w.x = cvt_pk_bf16(m[0], m[1]); w.y = cvt_pk_bf16(m[2], m[3]); w.z = cvt_pk_bf16(m[4], m[5]); w.w = cvt_pk_bf16(m[6], m[7]);
        M[i] = w;
    }
}

#define XB_TMO      128
#define XB_XCNT(j)  (256  + 64 * (j))
#define XB_XSUB(j)  (1280 + 64 * (j))
#define XB_XGEN(j)  (2304 + 64 * (j))
#define XB_TOP      3328
#define XB_TOPGEN   3392
#define XCD_BAR_WORDS 3456
#define XB_SPIN_CAP (1u << 18)

__device__ __forceinline__ unsigned xb_ld(unsigned* p)              { return __hip_atomic_load(p, __ATOMIC_RELAXED, __HIP_MEMORY_SCOPE_AGENT); }
__device__ __forceinline__ unsigned xb_add(unsigned* p, unsigned v) { return __hip_atomic_fetch_add(p, v, __ATOMIC_RELAXED, __HIP_MEMORY_SCOPE_AGENT); }
__device__ __forceinline__ unsigned xb_xcc_id() { return (unsigned)__builtin_amdgcn_s_getreg((3 << 11) | 20) & 0xFu; }
#define XB_SPIN(cond, bar) do { unsigned _sp = 0; while (cond) { __builtin_amdgcn_s_sleep(1); \
    if ((++_sp & 255u) == 0u) { if (xb_ld(&(bar)[XB_TMO])) break; if (_sp > XB_SPIN_CAP) { atomicAdd(&(bar)[XB_TMO], 1u); break; } } } } while (0)

struct XcdBarrier {
    unsigned* bar; unsigned x;
    volatile LAS unsigned* st;
};

__device__ __forceinline__ XcdBarrier xcd_barrier_post(unsigned* bar, volatile LAS unsigned* st) {
    XcdBarrier b; b.bar = bar; b.x = xb_xcc_id(); b.st = st;
    if (threadIdx.x == 0) (void)xb_add(&bar[XB_XCNT(b.x)], 1u);
    return b;
}
__device__ __forceinline__ void xcd_barrier_complete(unsigned* bar, unsigned x, unsigned& nloc, unsigned& nx) {
    const unsigned G = gridDim.x * gridDim.y * gridDim.z;
    unsigned sum, cnt, mine, sp = 0u;
    for (;;) {
        sum = 0u; cnt = 0u; mine = 0u;
#pragma unroll
        for (unsigned j = 0; j < 16; ++j) { const unsigned c = xb_ld(&bar[XB_XCNT(j)]); sum += c; cnt += (c > 0u) ? 1u : 0u; mine = (j == x) ? c : mine; }
        if (sum == G) break;
        __builtin_amdgcn_s_sleep(1);
        if ((++sp & 255u) == 0u) { if (xb_ld(&bar[XB_TMO])) break; if (sp > XB_SPIN_CAP) { atomicAdd(&bar[XB_TMO], 1u); break; } }
    }
    nloc = mine > 0u ? mine : 1u; nx = cnt > 0u ? cnt : 1u;
}

__device__ __forceinline__ void xcd_barrier(const XcdBarrier& b) {
    asm volatile("s_waitcnt vmcnt(0)" ::: "memory");
    __syncthreads();
    if (threadIdx.x == 0) {
        unsigned* bar = b.bar;
        __builtin_amdgcn_s_waitcnt(0);
        unsigned nloc = b.st[0], nx = b.st[1];
        if (nloc == 0u) { xcd_barrier_complete(bar, b.x, nloc, nx); b.st[0] = nloc; b.st[1] = nx; }
        const unsigned old = xb_add(&bar[XB_XSUB(b.x)], 1u);
        const unsigned gen = old / nloc;
        if (old + 1u == (gen + 1u) * nloc) {
            __builtin_amdgcn_fence(__ATOMIC_RELEASE, "agent");
            asm volatile("s_waitcnt vmcnt(0)" ::: "memory");
            const unsigned og = xb_add(&bar[XB_TOP], 1u);
            const unsigned tg = og / nx;
            if (og + 1u == (tg + 1u) * nx) xb_add(&bar[XB_TOPGEN], 1u);
            else XB_SPIN(xb_ld(&bar[XB_TOPGEN]) == tg, bar);
            __builtin_amdgcn_fence(__ATOMIC_ACQUIRE, "agent");
            xb_add(&bar[XB_XGEN(b.x)], 1u);
            asm volatile("s_waitcnt vmcnt(0)" ::: "memory");
        } else {
            XB_SPIN(xb_ld(&bar[XB_XGEN(b.x)]) == gen, bar);
            __builtin_amdgcn_fence(__ATOMIC_ACQUIRE, "agent");
            asm volatile("s_waitcnt vmcnt(0)" ::: "memory");
        }
    }
    __syncthreads();
}


constexpr int NPL = 13, NPH = 1 + 2 * NPL;
__global__ void __launch_bounds__(512, 2) fwd_kernel(Args a) {
    __shared__ __attribute__((aligned(16))) unsigned char shm[LDS_BYTES];
    cg::grid_group grid = cg::this_grid();
    Ctx c; c.in = a.in; c.X = a.out; c.ws = a.ws; c.lds = shm; c.tid = threadIdx.x; c.lane = c.tid & 63; c.wid = __builtin_amdgcn_readfirstlane(c.tid >> 6); c.fr = c.lane & 15; c.fq = c.lane >> 4; c.G = gridDim.x;
    PG8_LAS unsigned char* lds3 = (PG8_LAS unsigned char*)shm;
    volatile LAS unsigned* xb_st = (volatile LAS unsigned*)((LAS unsigned char*)shm + LDS_BYTES - 16);
    if (threadIdx.x < 4) xb_st[threadIdx.x] = 0u;
    __syncthreads();
    XcdBarrier xbar; xbar.bar = (unsigned*)(a.ws + WS_XBAR); xbar.x = 0; xbar.st = xb_st;
    if (a.coop != 0) xbar = xcd_barrier_post((unsigned*)(a.ws + WS_XBAR), xb_st);
    const int lo = a.ph_lo, hi = a.ph_hi; const bool coop = a.coop != 0;
    int ph = 0;
#define PH_BEGIN if (ph >= lo && ph < hi) { c.refresh();
#define PH_END if (coop && ph + 1 < hi) { if (ph == 0) grid.sync(); else xcd_barrier(xbar); } } ++ph;
    PH_BEGIN p0_phase(c); PH_END
#pragma unroll 1
    for (int l = 0; l < 2; ++l) {
#pragma unroll 1
        for (int f = 0; f < 2; ++f) {
            const int lf = l * 2 + f;
            PH_BEGIN
                pg8::Gemm g{c.wsb(WS_XB), c.wsb(WS_W13) + (size_t)lf * 5632 * 1024, T, 5632, 1024}; pg8::StaticOrder S; S.init(T, 5632, c.G, (int)blockIdx.x);
                pg8::EpiSwiglu E{c.wsb(WS_R)}; pg8::gemm_phase(lds3, g, S, E);
            PH_END
            PH_BEGIN
                pg8::Gemm g{c.wsb(WS_R), c.wsb(WS_W2) + (size_t)lf * 1024 * FF, T, 1024, FF}; pg8::StaticOrder S; S.init(T, 1024, c.G, (int)blockIdx.x);
                const int kprev = l * 3 + (f == 0 ? 0 : 2) - 1; const bool first = kprev < 0;
                pg8::EpiResF32 E{c.X, first ? a.in[I_X] : (const float*)c.X, (const f32x2*)(a.ws + WS_STATS), first ? (const float*)(a.ws + WS_IDENT) : a.in[I_LNG] + (size_t)kprev * 1024, first ? (const float*)(a.ws + WS_IDENT) + 1024 : a.in[I_LNB] + (size_t)kprev * 1024, ALPHA, 0.5f}; pg8::gemm_phase(lds3, g, S, E);
            PH_END
            PH_BEGIN ln_phase(c, a.in[I_LNG] + (size_t)(l * 3 + (f == 0 ? 0 : 2)) * 1024, a.in[I_LNB] + (size_t)(l * 3 + (f == 0 ? 0 : 2)) * 1024, l == 1 && f == 1); PH_END
            if (f == 0) {
                PH_BEGIN
                    pg8::Gemm g{c.wsb(WS_XB), c.wsb(WS_WIN) + (size_t)l * 6912 * 1024, T, 3840, 1024}; pg8::StaticOrder S; S.init(T, 3840, c.G, (int)blockIdx.x);
                    pg8::EpiZ E{c.wsb(WS_R), c.wsb(WS_HALO)}; pg8::gemm_phase(lds3, g, S, E);
                PH_END
                PH_BEGIN if (l == 0) prep_phase<0>(c, 0); else prep_phase<1>(c, 1);
                    __syncthreads(); gmlp_lru_phase(c, l, 0);
                PH_END
                PH_BEGIN scan_phase(c);
#ifdef PROBE_SCAN2
                    __syncthreads(); scan_phase(c);
#endif
                PH_END
                PH_BEGIN post_phase(c, l); PH_END
                PH_BEGIN
#pragma unroll 1
                    for (int i = 0; i < 3; ++i) {
                        { pg8::Gemm g{c.wsb(WS_XB), c.wsb(WS_WIN) + (size_t)l * 6912 * 1024 + (size_t)(3840 + 1024 * i) * 1024, T, 1024, 1024}; pg8::StaticOrder S; S.init(T, 1024, c.G, (int)blockIdx.x);
                          pg8::EpiBf E{c.wsb(WS_B1), 1024}; pg8::gemm_phase(lds3, g, S, E); }
                        { const bf16_t* oi = c.wsb(i == 0 ? WS_B0 : (i == 1 ? WS_B3 : WS_B4));
                          pg8::Gemm g{oi, c.wsb(WS_PB) + (size_t)(l * 3 + i) * 1024 * 512, T, 1024, 512}; pg8::StaticOrder S; S.init(T, 1024, c.G, (int)blockIdx.x);
                          pg8::EpiMergeF E{c.wsb(WS_B1), c.wsb(WS_LD), a.in[I_GATEB] + (size_t)(l * 3 + i) * 1024, i == 0 ? 1 : 0}; pg8::gemm_phase(lds3, g, S, E); }
                    }
                PH_END
                PH_BEGIN
                    pg8::Gemm g{c.wsb(WS_LD), c.wsb(WS_WO) + (size_t)l * 1024 * 1024, T, 1024, 1024}; pg8::StaticOrder S; S.init(T, 1024, c.G, (int)blockIdx.x);
                    pg8::EpiResF32 E{c.X, (const float*)c.X, (const f32x2*)(a.ws + WS_STATS), a.in[I_LNG] + (size_t)(l * 3) * 1024, a.in[I_LNB] + (size_t)(l * 3) * 1024, ALPHA, 1.0f}; pg8::gemm_phase(lds3, g, S, E);
                PH_END
                PH_BEGIN ln_phase(c, a.in[I_LNG] + (size_t)(l * 3 + 1) * 1024, a.in[I_LNB] + (size_t)(l * 3 + 1) * 1024, false); PH_END
            }
        }
    }
#undef PH_BEGIN
#undef PH_END
}

__global__ void digest_kernel(const unsigned short* src, float* out) {
    for (size_t i = (size_t)blockIdx.x * 256 + threadIdx.x; i < (size_t)T * DM; i += (size_t)gridDim.x * 256) out[i] = __uint_as_float(((unsigned)src[i]) << 16);
}
extern "C" void kernel_launch(void* const* d_in, const int* in_sizes, int n_in, void* d_out, int out_size, void* d_ws, size_t ws_size, hipStream_t stream) {
    static int grid = 0;
    if (grid == 0) {
        if (n_in != 35 || out_size != T * DM || ws_size < WS_END) { fprintf(stderr, "kernel_launch: unexpected shapes (n_in %d out %d ws %zu need %zu)\n", n_in, out_size, ws_size, (size_t)WS_END); grid = -1; return; }
        int dev = 0, cus = 0, per_cu = 0;
        (void)hipGetDevice(&dev); (void)hipDeviceGetAttribute(&cus, hipDeviceAttributeMultiprocessorCount, dev);
        if (hipOccupancyMaxActiveBlocksPerMultiprocessor(&per_cu, (const void*)fwd_kernel, 512, 0) != hipSuccess || per_cu < 1) { fprintf(stderr, "kernel_launch: occupancy query says %d\n", per_cu); per_cu = 1; }
        (void)hipGetLastError();
        grid = cus;
        if (grid < 65) { fprintf(stderr, "kernel_launch: grid %d too small\n", grid); grid = -1; return; }
    }
    if (grid < 0) return;
    Args a{};
    for (int i = 0; i < 35; ++i) a.in[i] = (const float*)d_in[i];
    a.out = (float*)d_out; a.ws = (unsigned char*)d_ws;
#if ONE_LAUNCH
    if (hipMemsetAsync((char*)d_ws + WS_XBAR, 0, XCD_BAR_WORDS * sizeof(unsigned), stream) != hipSuccess) fprintf(stderr, "kernel_launch: memset of barrier words failed\n");
    a.ph_lo = 0; a.ph_hi = NPH; a.coop = 1; a.pad = 0;
    void* args[] = {&a};
    hipError_t e = hipLaunchCooperativeKernel((const void*)fwd_kernel, dim3(grid), dim3(512), args, 0, stream);
    if (e != hipSuccess) fprintf(stderr, "cooperative launch failed: %s (grid %d)\n", hipGetErrorString(e), grid);
#else
    for (int p = 0; p < NPH && p <= STOP_AFTER; ++p) {
        a.ph_lo = p; a.ph_hi = p + 1; a.coop = 0; a.pad = 0;
        hipLaunchKernelGGL(fwd_kernel, dim3(grid), dim3(512), 0, stream, a);
    }
    if (DIGEST_OFF_MIB > 0) hipLaunchKernelGGL(digest_kernel, dim3(2048), dim3(256), 0, stream, (const unsigned short*)((const char*)d_ws + (size_t)DIGEST_OFF_MIB * MiB), (float*)d_out);
#endif
}
```
